# Optimizing an MI355X kernel written in HIP

```python
import jax, jax.numpy as jnp
from jax import lax
import numpy as np

D_MODEL = 2048
BATCH = 16
SEQ = 2048
DEPTH = 2

CHUNK = 64
D_CONV = D_MODEL // 2
D_RET = D_MODEL - D_CONV
RET_HEAD_DIM = 128
RET_HEADS = D_RET // RET_HEAD_DIM
CONV_WIDTH = 3
D_IN_PROJ = 3 * D_CONV + 4 * D_RET
ROPE_BASE = 10000.0
N_GROUPS = 4
EXPERTS_PER_GROUP = 8
N_EXPERTS = N_GROUPS * EXPERTS_PER_GROUP
TOP_K = 2
D_EXPERT = D_MODEL // 2
MOE_BLOCK = 128
EPS = 1e-6

kernel_name = "hybrid_conv_retention_hmoe_trunk"


def rmsnorm(x, g):
    x32 = x.astype(jnp.float32)
    y = x32 * lax.rsqrt(jnp.mean(x32 * x32, axis=-1, keepdims=True) + EPS)
    return (y * g.astype(jnp.float32)).astype(x.dtype)


def head_rmsnorm(x):
    x32 = x.astype(jnp.float32)
    return x32 * lax.rsqrt(jnp.mean(x32 * x32, axis=-1, keepdims=True) + EPS)


def rotary(x, pos):
    half = x.shape[-1] // 2
    inv = ROPE_BASE ** (-jnp.arange(half, dtype=jnp.float32) / half)
    ang = pos[:, None] * inv[None, :]
    cos = jnp.cos(ang)[None, :, None, :]
    sin = jnp.sin(ang)[None, :, None, :]
    x32 = x.astype(jnp.float32)
    x1, x2 = x32[..., :half], x32[..., half:]
    return jnp.concatenate([x1 * cos - x2 * sin, x2 * cos + x1 * sin], axis=-1)


def retention(q, k, v):
    bsz, seq, nh, dh = q.shape
    n_chunks = seq // CHUNK
    log_g = jnp.log1p(-jnp.exp2(-5.0 - jnp.arange(nh, dtype=jnp.float32)))
    idx = jnp.arange(CHUNK, dtype=jnp.float32)
    d_intra = jnp.exp(log_g[:, None, None] * jnp.abs(idx[:, None] - idx[None, :]))
    q_dec = jnp.exp(log_g[None, :] * (idx[:, None] + 1.0))
    k_dec = jnp.exp(log_g[None, :] * (CHUNK - 1.0 - idx[:, None]))
    chunk_dec = jnp.exp(log_g * CHUNK)

    qc = q.reshape(bsz, n_chunks, CHUNK, nh, dh)
    kc = k.reshape(bsz, n_chunks, CHUNK, nh, dh)
    vc = v.reshape(bsz, n_chunks, CHUNK, nh, dh)

    s = jnp.einsum('bnihd,bnjhd->bnhij', qc, kc) * d_intra[None, None]
    o_intra = jnp.einsum('bnhij,bnjhe->bnihe', s, vc)

    def step(state, inp):
        qn, kn, vn = inp
        cross = jnp.einsum('bihd,bhde->bihe', qn * q_dec[None, :, :, None], state)
        state = state * chunk_dec[None, :, None, None] + jnp.einsum(
            'bjhd,bjhe->bhde', kn * k_dec[None, :, :, None], vn)
        return state, cross

    r0 = jnp.zeros((bsz, nh, dh, dh), jnp.float32)
    xs = (qc.transpose(1, 0, 2, 3, 4), kc.transpose(1, 0, 2, 3, 4), vc.transpose(1, 0, 2, 3, 4))
    _, cross = lax.scan(step, r0, xs)
    out = o_intra + cross.transpose(1, 0, 2, 3, 4)
    return out.reshape(bsz, seq, nh, dh)


def token_mixer(h, w_in, conv_w, w_out):
    bsz, seq, _ = h.shape
    z = h @ w_in
    b_g, c_g, v_c, q, k, v, g = jnp.split(
        z, [D_CONV, 2 * D_CONV, 3 * D_CONV, 3 * D_CONV + D_RET,
            3 * D_CONV + 2 * D_RET, 3 * D_CONV + 3 * D_RET], axis=-1)

    u = c_g * v_c
    y_conv = lax.conv_general_dilated(
        u, conv_w[:, None, :], window_strides=(1,), padding=[(CONV_WIDTH - 1, 0)],
        dimension_numbers=('NWC', 'WIO', 'NWC'), feature_group_count=D_CONV)
    conv_out = b_g * y_conv

    pos = jnp.arange(seq, dtype=jnp.float32)
    qh = rotary(q.reshape(bsz, seq, RET_HEADS, RET_HEAD_DIM), pos)
    kh = rotary(k.reshape(bsz, seq, RET_HEADS, RET_HEAD_DIM), pos) * (RET_HEAD_DIM ** -0.5)
    vh = v.reshape(bsz, seq, RET_HEADS, RET_HEAD_DIM).astype(jnp.float32)
    o = head_rmsnorm(retention(qh, kh, vh)).reshape(bsz, seq, D_RET)
    ret_out = (o * jax.nn.silu(g.astype(jnp.float32))).astype(h.dtype)

    return jnp.concatenate([conv_out, ret_out], axis=-1) @ w_out


def hierarchical_moe(h, w_group, b_group, w_router, b_router, w1, w3, w2):
    bsz, seq, dm = h.shape
    n_tok = bsz * seq
    xt = h.reshape(n_tok, dm)

    gl = (xt @ w_group).astype(jnp.float32) + b_group.astype(jnp.float32)
    g_sel = jnp.argmax(gl, axis=-1)
    p_g = jnp.take_along_axis(jax.nn.softmax(gl, axis=-1), g_sel[:, None], axis=1)[:, 0]
    el = ((xt @ w_router).astype(jnp.float32) + b_router.astype(jnp.float32)).reshape(
        n_tok, N_GROUPS, EXPERTS_PER_GROUP)
    el_sel = jnp.take_along_axis(el, g_sel[:, None, None], axis=1)[:, 0]
    top_v, top_i = lax.top_k(el_sel, TOP_K)
    gate = p_g[:, None] * jax.nn.softmax(top_v, axis=-1)
    expert = g_sel[:, None] * EXPERTS_PER_GROUP + top_i

    n_assign = n_tok * TOP_K
    e_flat = expert.reshape(n_assign).astype(jnp.int32)
    w_flat = gate.reshape(n_assign)
    tok = jnp.repeat(jnp.arange(n_tok, dtype=jnp.int32), TOP_K)
    order = jnp.argsort(e_flat)
    e_s, tok_s, w_s = e_flat[order], tok[order], w_flat[order]
    counts = jnp.bincount(e_flat, length=N_EXPERTS)
    starts = jnp.cumsum(counts) - counts
    pcounts = (counts + MOE_BLOCK - 1) // MOE_BLOCK * MOE_BLOCK
    pends = jnp.cumsum(pcounts)
    pstarts = pends - pcounts
    dest = pstarts[e_s] + jnp.arange(n_assign, dtype=jnp.int32) - starts[e_s]
    n_blocks = -(-n_assign // MOE_BLOCK) + N_EXPERTS
    n_rows = n_blocks * MOE_BLOCK
    row_tok = jnp.full((n_rows,), n_tok, jnp.int32).at[dest].set(tok_s)
    row_w = jnp.zeros((n_rows,), jnp.float32).at[dest].set(w_s)
    blk_e = jnp.minimum(
        jnp.searchsorted(pends, jnp.arange(n_blocks, dtype=jnp.int32) * MOE_BLOCK, side='right'),
        N_EXPERTS - 1)
    xpad = jnp.concatenate([xt, jnp.zeros((1, dm), xt.dtype)], axis=0)

    def block_fn(args):
        idx, e = args
        xb = xpad[idx]
        hid = jax.nn.silu(xb @ w1[e]) * (xb @ w3[e])
        return hid @ w2[e]

    yb = lax.map(block_fn, (row_tok.reshape(n_blocks, MOE_BLOCK), blk_e))
    yb = yb.reshape(n_rows, dm) * row_w[:, None].astype(yb.dtype)
    y = jnp.zeros((n_tok + 1, dm), yb.dtype).at[row_tok].add(yb)
    return y[:n_tok].reshape(bsz, seq, dm)


def setup_inputs(seed: int = 0) -> dict:
    key = jax.random.key(seed)
    ks = jax.random.split(key, 14)
    f32 = jnp.float32
    nrm = lambda k, shape, scale: jax.random.normal(k, shape, f32) * scale
    return {
        "x": nrm(ks[0], (BATCH, SEQ, D_MODEL), 1.0),
        "norm_mix_g": 1.0 + nrm(ks[1], (DEPTH, D_MODEL), 0.05),
        "w_in": nrm(ks[2], (DEPTH, D_MODEL, D_IN_PROJ), D_MODEL ** -0.5),
        "conv_w": nrm(ks[3], (DEPTH, CONV_WIDTH, D_CONV), CONV_WIDTH ** -0.5),
        "w_out": nrm(ks[4], (DEPTH, D_CONV + D_RET, D_MODEL), (D_CONV + D_RET) ** -0.5),
        "norm_ffn_g": 1.0 + nrm(ks[5], (DEPTH, D_MODEL), 0.05),
        "w_group": nrm(ks[6], (DEPTH, D_MODEL, N_GROUPS), D_MODEL ** -0.5),
        "b_group": nrm(ks[7], (DEPTH, N_GROUPS), 0.01),
        "w_router": nrm(ks[8], (DEPTH, D_MODEL, N_EXPERTS), D_MODEL ** -0.5),
        "b_router": nrm(ks[9], (DEPTH, N_EXPERTS), 0.01),
        "w_expert_gate": nrm(ks[10], (DEPTH, N_EXPERTS, D_MODEL, D_EXPERT), D_MODEL ** -0.5),
        "w_expert_up": nrm(ks[11], (DEPTH, N_EXPERTS, D_MODEL, D_EXPERT), D_MODEL ** -0.5),
        "w_expert_down": nrm(ks[12], (DEPTH, N_EXPERTS, D_EXPERT, D_MODEL), D_EXPERT ** -0.5),
        "final_norm_g": 1.0 + nrm(ks[13], (D_MODEL,), 0.05),
    }


def reference(x, norm_mix_g, w_in, conv_w, w_out, norm_ffn_g, w_group, b_group,
              w_router, b_router, w_expert_gate, w_expert_up, w_expert_down, final_norm_g):
    for l in range(DEPTH):
        h = rmsnorm(x, norm_mix_g[l])
        x = x + token_mixer(h, w_in[l], conv_w[l], w_out[l])
        h = rmsnorm(x, norm_ffn_g[l])
        x = x + hierarchical_moe(h, w_group[l], b_group[l], w_router[l], b_router[l],
                                 w_expert_gate[l], w_expert_up[l], w_expert_down[l])
    return rmsnorm(x, final_norm_g)
```

```cpp
#include <hip/hip_runtime.h>
#include <cstdio>
#include <cstdint>

#ifndef DUP_MASK
#define DUP_MASK 0
#endif
#ifndef MK_PER_PHASE
#define MK_PER_PHASE 0
#ifndef NCV_SET
#define NCV_SET 40
#endif
#ifndef P2_CHUNKS
#define P2_CHUNKS 3
#endif
#endif

constexpr int T = 32768, D = 2048, NZ = 7168, SEQ = 2048, NHEAD = 8, HD = 128, CHUNK = 64;
constexpr int NE = 32, DE = 1024, NLAYER = 2;
constexpr int MAXROWS = 65536 + NE * 256;
constexpr int MAXTILES = MAXROWS / 256;
constexpr float EPS = 1e-6f;
constexpr int NPHASE = 1 + 7 * NLAYER;

constexpr size_t MiB = 1u << 20;
constexpr size_t WS_CTL = 0, CTL_ZERO_BYTES = 64 * 1024;
constexpr size_t WS_ROPE = 1 * MiB;
constexpr size_t WS_WR = 2 * MiB;
constexpr size_t WS_INFO = 3 * MiB;
constexpr size_t WS_LIST = 4 * MiB;
constexpr size_t WS_WIN = 8 * MiB;
constexpr size_t WS_WOUT = 64 * MiB;
constexpr size_t WS_W13 = 80 * MiB;
constexpr size_t WS_W2 = 336 * MiB;
constexpr size_t WS_H8 = 464 * MiB;
constexpr size_t WS_WIN8 = 528 * MiB;
constexpr size_t WS_H = 848 * MiB;
constexpr size_t WS_Z = 976 * MiB;
constexpr size_t WS_HID = WS_Z;
constexpr size_t WS_YB = WS_Z + 144 * MiB;
constexpr size_t WS_Y = 1424 * MiB;
constexpr size_t WS_X1 = 1552 * MiB;
constexpr size_t WS_END = 1808 * MiB;
static_assert((size_t)MAXROWS * 1024 * 2 <= 144 * MiB && (size_t)MAXROWS * 2048 * 2 <= 288 * MiB && 144 + 288 <= 448, "overlay");
constexpr int CW_BAR = 0, CW_CNT = 4096, CW_Q = 4352, CW_Q2 = 4416;

constexpr int MISC_OFF = 143360;
constexpr int LDS_BYTES = 147456;
constexpr int MW_BAR = 0, MW_TSTART = 16, MW_CNT = 64, MW_TILE = 128;
static_assert(MISC_OFF + (MW_TILE + 320) * 4 <= LDS_BYTES, "LDS map");

#define GAS __attribute__((address_space(1)))
#define LAS __attribute__((address_space(3)))
typedef unsigned short bf16;
typedef unsigned v4u __attribute__((ext_vector_type(4)));
typedef unsigned v2u __attribute__((ext_vector_type(2)));
typedef float f32x4 __attribute__((ext_vector_type(4)));
typedef float f32x2 __attribute__((ext_vector_type(2)));
typedef float f32x16 __attribute__((ext_vector_type(16)));
typedef short bf16x8 __attribute__((ext_vector_type(8)));
typedef int i32x4 __attribute__((ext_vector_type(4)));
#define LDS_WAIT() asm volatile("s_waitcnt lgkmcnt(0)" ::: "memory")
#define VM_WAIT() asm volatile("s_waitcnt vmcnt(0)" ::: "memory")
typedef __bf16 bf16v2 __attribute__((ext_vector_type(2)));
__device__ __forceinline__ unsigned pk2(float lo, float hi) { const bf16v2 v = __builtin_convertvector((f32x2){lo, hi}, bf16v2); return __builtin_bit_cast(unsigned, v); }
__device__ __forceinline__ unsigned f2bf(float f) { return pk2(f, 0.f) & 0xffffu; }
__device__ __forceinline__ float bflo(unsigned w) { return __builtin_bit_cast(float, w << 16); }
__device__ __forceinline__ float bfhi(unsigned w) { return __builtin_bit_cast(float, w & 0xffff0000u); }
__device__ __forceinline__ float bf2f(bf16 b) { return __builtin_bit_cast(float, ((unsigned)b) << 16); }
__device__ __forceinline__ float shx(float v, int o, int lane) { return __builtin_bit_cast(float, __builtin_amdgcn_ds_bpermute((lane ^ o) << 2, __builtin_bit_cast(int, v))); }
__device__ __forceinline__ float wave_sum(float v, int lane) {
#pragma unroll
    for (int o = 1; o < 64; o <<= 1) v += shx(v, o, lane);
    return v;
}

#define XB_TMO      128
#define XB_XCNT(j)  (256  + 64 * (j))
#define XB_XSUB(j)  (1280 + 64 * (j))
#define XB_XGEN(j)  (2304 + 64 * (j))
#define XB_TOP      3328
#define XB_TOPGEN   3392
#define XCD_BAR_WORDS 3456
#define XB_SPIN_CAP (1u << 20)
__device__ __forceinline__ unsigned xb_ld(unsigned* p)              { return __hip_atomic_load(p, __ATOMIC_RELAXED, __HIP_MEMORY_SCOPE_AGENT); }
__device__ __forceinline__ unsigned xb_add(unsigned* p, unsigned v) { return __hip_atomic_fetch_add(p, v, __ATOMIC_RELAXED, __HIP_MEMORY_SCOPE_AGENT); }
__device__ __forceinline__ unsigned xb_xcc_id() { return (unsigned)__builtin_amdgcn_s_getreg((3 << 11) | 20) & 0xFu; }
#define XB_SPIN(cond, bar) do { unsigned _sp = 0; while (cond) { __builtin_amdgcn_s_sleep(1); \
    if ((++_sp & 255u) == 0u) { if (xb_ld(&(bar)[XB_TMO])) break; if (_sp > XB_SPIN_CAP) { atomicAdd(&(bar)[XB_TMO], 1u); break; } } } } while (0)
struct XcdBarrier { unsigned* bar; unsigned x; volatile LAS unsigned* st; };
__device__ __forceinline__ XcdBarrier xcd_barrier_post(unsigned* bar, volatile LAS unsigned* st) {
    XcdBarrier b; b.bar = bar; b.x = xb_xcc_id(); b.st = st;
    if (threadIdx.x == 0) (void)xb_add(&bar[XB_XCNT(b.x)], 1u);
    return b;
}
__device__ __forceinline__ void xcd_barrier_complete(unsigned* bar, unsigned x, unsigned& nloc, unsigned& nx) {
    const unsigned G = gridDim.x * gridDim.y * gridDim.z;
    unsigned sum, cnt, mine, sp = 0u;
    for (;;) {
        sum = 0u; cnt = 0u; mine = 0u;
#pragma unroll
        for (unsigned j = 0; j < 16; ++j) { const unsigned c = xb_ld(&bar[XB_XCNT(j)]); sum += c; cnt += (c > 0u) ? 1u : 0u; mine = (j == x) ? c : mine; }
        if (sum == G) break;
        __builtin_amdgcn_s_sleep(1);
        if ((++sp & 255u) == 0u) { if (xb_ld(&bar[XB_TMO])) break; if (sp > XB_SPIN_CAP) { atomicAdd(&bar[XB_TMO], 1u); break; } }
    }
    nloc = mine > 0u ? mine : 1u; nx = cnt > 0u ? cnt : 1u;
}
__device__ __forceinline__ void xcd_barrier(const XcdBarrier& b) {
    asm volatile("s_waitcnt vmcnt(0)" ::: "memory");
    __syncthreads();
    if (threadIdx.x == 0) {
        unsigned* bar = b.bar; unsigned bx = b.x;
        asm volatile("" : "+s"(bar), "+s"(bx));
        __builtin_amdgcn_s_waitcnt(0);
        unsigned nloc = b.st[0], nx = b.st[1];
        if (nloc == 0u) { xcd_barrier_complete(bar, bx, nloc, nx); b.st[0] = nloc; b.st[1] = nx; }
        const unsigned old = xb_add(&bar[XB_XSUB(bx)], 1u);
        const unsigned gen = old / nloc;
        if (old + 1u == (gen + 1u) * nloc) {
            __builtin_amdgcn_fence(__ATOMIC_RELEASE, "agent");
            asm volatile("s_waitcnt vmcnt(0)" ::: "memory");
            const unsigned og = xb_add(&bar[XB_TOP], 1u);
            const unsigned tg = og / nx;
            if (og + 1u == (tg + 1u) * nx) xb_add(&bar[XB_TOPGEN], 1u);
            else XB_SPIN(xb_ld(&bar[XB_TOPGEN]) == tg, bar);
            __builtin_amdgcn_fence(__ATOMIC_ACQUIRE, "agent");
            xb_add(&bar[XB_XGEN(bx)], 1u);
            asm volatile("s_waitcnt vmcnt(0)" ::: "memory");
        } else {
            XB_SPIN(xb_ld(&bar[XB_XGEN(bx)]) == gen, bar);
            __builtin_amdgcn_fence(__ATOMIC_ACQUIRE, "agent");
            asm volatile("s_waitcnt vmcnt(0)" ::: "memory");
        }
    }
    __syncthreads();
}

namespace pg8 {
#define PG8_LAS __attribute__((address_space(3)))
typedef unsigned short bf16_t;
typedef unsigned u32x4 __attribute__((ext_vector_type(4)));
constexpr int BM = 256, BK = 64, HALF = 128, HTB = HALF * BK * 2, STAGE_BYTES = 8 * HTB, NXCD = 8, WGM = 8;
__host__ __device__ __forceinline__ int lds_byte(int r, int c) { const int st = (r >> 4) * 2 + (c >> 5), rr = r & 15, cc = c & 31, ob = rr * 64 + cc * 2; return st * 1024 + (ob ^ (((ob >> 9) & 1) << 5)); }
__host__ __device__ __forceinline__ void stage_rc(int b, int& R, int& C) { const int st = b / 1024, sb = b % 1024, swz = sb ^ (((sb >> 9) & 1) << 5); R = (st >> 1) * 16 + swz / 64; C = (st & 1) * 32 + (swz % 64) / 2; }
__host__ __device__ __forceinline__ int perm32(int rho) { const int n = rho >> 4, i = rho & 15; return 8 * (i >> 2) + 4 * n + (i & 3); }

struct Unit { int pm, pn, e; };
typedef int i32x8 __attribute__((ext_vector_type(8)));
typedef int i32x4v __attribute__((ext_vector_type(4)));
struct Frag { i32x8 v; };
__device__ __forceinline__ Frag ldfrag2(const PG8_LAS unsigned char* p) { Frag f; f.v = __builtin_shufflevector(*(const PG8_LAS i32x4v*)p, *(const PG8_LAS i32x4v*)(p + 1024), 0, 1, 2, 3, 4, 5, 6, 7); return f; }
__device__ __forceinline__ bf16x8 fhalf(const Frag& f, int k) { const i32x4v h = k ? __builtin_shufflevector(f.v, f.v, 4, 5, 6, 7) : __builtin_shufflevector(f.v, f.v, 0, 1, 2, 3); return __builtin_bit_cast(bf16x8, h); }
__device__ __forceinline__ unsigned cvt_pk_bf16(float lo, float hi) { unsigned r; asm volatile("v_cvt_pk_bf16_f32 %0, %1, %2" : "=v"(r) : "v"(lo), "v"(hi)); return r; }

__device__ __forceinline__ bool order_next(int nM, int nN, int G, int c, int i, int& pm, int& pn) {
    const int nwg = nM * nN; const long L = (long)i * G + c; if (L >= nwg) return false;
    int wgid = (int)L; { const int q = nwg / NXCD, r = nwg % NXCD, xcd = wgid % NXCD, off = wgid / NXCD; wgid = (xcd < r ? xcd * (q + 1) : r * (q + 1) + (xcd - r) * q) + off; }
    const int nig = WGM * nN, gid = wgid / nig, fm = gid * WGM, gsz = (nM - fm) < WGM ? (nM - fm) : WGM;
    pm = fm + ((wgid % nig) % gsz); pn = (wgid % nig) / gsz; return true;
}
struct DenseOrder {
    int nM, nN, G, c, KB; const char* A; const char* Bt;
    __device__ __forceinline__ bool next(int i, Unit& u) const { u.e = 0; return order_next(nM, nN, G, c, i, u.pm, u.pn); }
    __device__ __forceinline__ const char* a_base(const Unit& u) const { return A + (size_t)u.pm * (size_t)BM * KB; }
    __device__ __forceinline__ const char* b_base(const Unit& u) const { return Bt + (size_t)u.pn * (size_t)BM * KB; }
    __device__ __forceinline__ void a_offs(const Unit&, const int (&R)[2], const int (&Cb)[2], unsigned (&vo)[2][2]) const {
#pragma unroll
        for (int h = 0; h < 2; ++h)
#pragma unroll
            for (int i = 0; i < 2; ++i) vo[h][i] = (unsigned)((h * HALF + R[i]) * KB + Cb[i]);
    }
    __device__ __forceinline__ void a_idx(const Unit&, const int (&R)[2], int (&tok)[2][2]) const {
#pragma unroll
        for (int h = 0; h < 2; ++h)
#pragma unroll
            for (int i = 0; i < 2; ++i) tok[h][i] = h * HALF + R[i]; }
    __device__ __forceinline__ void a_vo(const int (&tok)[2][2], const int (&Cb)[2], unsigned (&vo)[2][2]) const {
#pragma unroll
        for (int h = 0; h < 2; ++h)
#pragma unroll
            for (int i = 0; i < 2; ++i) vo[h][i] = (unsigned)tok[h][i] * (unsigned)KB + (unsigned)Cb[i]; }
};
template <bool GATHER> struct MoeOrder {
    int nT, G, c, KB; const char* A; const char* Bt; size_t bexp;
    const int* list; const LAS int* tile_e; const LAS int* tstart; const LAS int* cnt;
    __device__ __forceinline__ bool next(int i, Unit& u) const { if (!order_next(nT, 8, G, c, i, u.pm, u.pn)) return false; u.e = tile_e[u.pm]; return true; }
    __device__ __forceinline__ const char* a_base(const Unit& u) const { return GATHER ? A : A + (size_t)u.pm * (size_t)BM * KB; }
    __device__ __forceinline__ const char* b_base(const Unit& u) const { return Bt + (size_t)u.e * bexp + (size_t)u.pn * (size_t)BM * KB; }
    __device__ __forceinline__ void a_offs(const Unit& u, const int (&R)[2], const int (&Cb)[2], unsigned (&vo)[2][2]) const {
        if (GATHER) {
            const int base = (u.pm - tstart[u.e]) * BM, n = cnt[u.e]; const int* le = list + (size_t)u.e * T;
            int tok[2][2];
#pragma unroll
            for (int h = 0; h < 2; ++h)
#pragma unroll
                for (int i = 0; i < 2; ++i) { const int s = base + h * HALF + R[i]; tok[h][i] = le[s < n ? s : 0]; }
#pragma unroll
            for (int h = 0; h < 2; ++h)
#pragma unroll
                for (int i = 0; i < 2; ++i) vo[h][i] = (unsigned)tok[h][i] * (unsigned)KB + (unsigned)Cb[i];
        } else {
#pragma unroll
            for (int h = 0; h < 2; ++h)
#pragma unroll
                for (int i = 0; i < 2; ++i) vo[h][i] = (unsigned)((h * HALF + R[i]) * KB + Cb[i]);
        }
    }
    __device__ __forceinline__ void a_idx(const Unit& u, const int (&R)[2], int (&tok)[2][2]) const {
        if (GATHER) { const int base = (u.pm - tstart[u.e]) * BM, n = cnt[u.e]; const int* le = list + (size_t)u.e * T;
#pragma unroll
            for (int h = 0; h < 2; ++h)
#pragma unroll
                for (int i = 0; i < 2; ++i) { const int s = base + h * HALF + R[i]; tok[h][i] = le[s < n ? s : 0]; } }
        else {
#pragma unroll
            for (int h = 0; h < 2; ++h)
#pragma unroll
                for (int i = 0; i < 2; ++i) tok[h][i] = h * HALF + R[i]; } }
    __device__ __forceinline__ void a_vo(const int (&tok)[2][2], const int (&Cb)[2], unsigned (&vo)[2][2]) const {
#pragma unroll
        for (int h = 0; h < 2; ++h)
#pragma unroll
            for (int i = 0; i < 2; ++i) vo[h][i] = (unsigned)tok[h][i] * (unsigned)KB + (unsigned)Cb[i]; }
};

struct EpiBf16 {
    static constexpr bool PERM = true;
    bf16_t* O; int ldc; int coff;
    __device__ __forceinline__ void operator()(const f32x4 (&acc)[2][2][4][2], const Unit& u, int wr, int wc, int fr, int fq) const {
        const int row0 = u.pm * BM + wr * 64 + fr, col0 = coff + u.pn * BM + wc * 32 + 8 * fq;
#pragma unroll
        for (int ai = 0; ai < 2; ++ai)
#pragma unroll
            for (int m = 0; m < 4; ++m) { bf16_t* rowp = O + (size_t)(row0 + ai * HALF + m * 16) * ldc + col0;
#pragma unroll
                for (int bj = 0; bj < 2; ++bj) { const f32x4 v0 = acc[ai][bj][m][0], v1 = acc[ai][bj][m][1];
                    u32x4 w; w.x = cvt_pk_bf16(v0[0], v0[1]); w.y = cvt_pk_bf16(v0[2], v0[3]); w.z = cvt_pk_bf16(v1[0], v1[1]); w.w = cvt_pk_bf16(v1[2], v1[3]);
                    *(u32x4*)(rowp + bj * HALF) = w; } }
    }
};
struct EpiFp8 {
    static constexpr bool PERM = true;
    unsigned char* O; int ldc;
    __device__ __forceinline__ void operator()(const f32x4 (&acc)[2][2][4][2], const Unit& u, int wr, int wc, int fr, int fq) const {
        const int row0 = u.pm * BM + wr * 64 + fr, col0 = u.pn * BM + wc * 32 + 8 * fq;
        typedef int i32x2 __attribute__((ext_vector_type(2)));
#pragma unroll
        for (int ai = 0; ai < 2; ++ai)
#pragma unroll
            for (int m = 0; m < 4; ++m) { unsigned char* rowp = O + (size_t)(row0 + ai * HALF + m * 16) * ldc + col0;
#pragma unroll
                for (int bj = 0; bj < 2; ++bj) { const f32x4 v0 = acc[ai][bj][m][0], v1 = acc[ai][bj][m][1];
                    int w0 = 0, w1 = 0; w0 = __builtin_amdgcn_cvt_pk_fp8_f32(v0[0], v0[1], w0, false); w0 = __builtin_amdgcn_cvt_pk_fp8_f32(v0[2], v0[3], w0, true);
                    w1 = __builtin_amdgcn_cvt_pk_fp8_f32(v1[0], v1[1], w1, false); w1 = __builtin_amdgcn_cvt_pk_fp8_f32(v1[2], v1[3], w1, true);
                    *(i32x2*)(rowp + bj * HALF) = (i32x2){w0, w1}; } }
    }
};
struct EpiConvIn {
    static constexpr bool PERM = true;
    bf16_t* O; int ldc;
    __device__ __forceinline__ void operator()(const f32x4 (&acc)[2][2][4][2], const Unit& u, int wr, int wc, int fr, int fq) const {
        const int row0 = u.pm * BM + wr * 64 + fr;
        if (u.pn < 4) { const int col0 = u.pn * BM + wc * 32 + 8 * fq;
#pragma unroll
            for (int ai = 0; ai < 2; ++ai)
#pragma unroll
                for (int m = 0; m < 4; ++m) { bf16_t* rowp = O + (size_t)(row0 + ai * HALF + m * 16) * ldc + col0;
#pragma unroll
                    for (int bj = 0; bj < 2; ++bj) { const f32x4 v0 = acc[ai][bj][m][0], v1 = acc[ai][bj][m][1];
                        u32x4 w; w.x = cvt_pk_bf16(v0[0], v0[1]); w.y = cvt_pk_bf16(v0[2], v0[3]); w.z = cvt_pk_bf16(v1[0], v1[1]); w.w = cvt_pk_bf16(v1[2], v1[3]);
                        *(u32x4*)(rowp + bj * HALF) = w; } } }
        else { const int col0 = 1024 + (u.pn - 4) * HALF + wc * 32 + 8 * fq;
#pragma unroll
            for (int ai = 0; ai < 2; ++ai)
#pragma unroll
                for (int m = 0; m < 4; ++m) { const f32x4 c0 = acc[ai][0][m][0], c1 = acc[ai][0][m][1], v0 = acc[ai][1][m][0], v1 = acc[ai][1][m][1];
                    u32x4 w; w.x = cvt_pk_bf16(c0[0] * v0[0], c0[1] * v0[1]); w.y = cvt_pk_bf16(c0[2] * v0[2], c0[3] * v0[3]); w.z = cvt_pk_bf16(c1[0] * v1[0], c1[1] * v1[1]); w.w = cvt_pk_bf16(c1[2] * v1[2], c1[3] * v1[3]);
                    *(u32x4*)(O + (size_t)(row0 + ai * HALF + m * 16) * ldc + col0) = w; } }
    }
};
struct EpiResid {
    static constexpr bool PERM = true;
    bf16_t* X; int ldc;
    __device__ __forceinline__ void operator()(const f32x4 (&acc)[2][2][4][2], const Unit& u, int wr, int wc, int fr, int fq) const {
        const int row0 = u.pm * BM + wr * 64 + fr, col0 = u.pn * BM + wc * 32 + 8 * fq;
        u32x4 rs[2][4][2];
#pragma unroll
        for (int ai = 0; ai < 2; ++ai)
#pragma unroll
            for (int m = 0; m < 4; ++m) { const bf16_t* rowp = X + (size_t)(row0 + ai * HALF + m * 16) * ldc + col0;
#pragma unroll
                for (int bj = 0; bj < 2; ++bj) rs[ai][m][bj] = *(const u32x4*)(rowp + bj * HALF); }
#pragma unroll
        for (int ai = 0; ai < 2; ++ai)
#pragma unroll
            for (int m = 0; m < 4; ++m) { bf16_t* rowp = X + (size_t)(row0 + ai * HALF + m * 16) * ldc + col0;
#pragma unroll
                for (int bj = 0; bj < 2; ++bj) { const u32x4 bs = rs[ai][m][bj]; const f32x4 v0 = acc[ai][bj][m][0], v1 = acc[ai][bj][m][1];
                    u32x4 w; w.x = cvt_pk_bf16(v0[0] + __builtin_bit_cast(float, bs.x << 16), v0[1] + __builtin_bit_cast(float, bs.x & 0xffff0000u)); w.y = cvt_pk_bf16(v0[2] + __builtin_bit_cast(float, bs.y << 16), v0[3] + __builtin_bit_cast(float, bs.y & 0xffff0000u));
                    w.z = cvt_pk_bf16(v1[0] + __builtin_bit_cast(float, bs.z << 16), v1[1] + __builtin_bit_cast(float, bs.z & 0xffff0000u)); w.w = cvt_pk_bf16(v1[2] + __builtin_bit_cast(float, bs.w << 16), v1[3] + __builtin_bit_cast(float, bs.w & 0xffff0000u));
                    *(u32x4*)(rowp + bj * HALF) = w; } }
    }
};
struct EpiSwiglu {
    static constexpr bool PERM = true;
    unsigned char* O;
    __device__ __forceinline__ void operator()(const f32x4 (&acc)[2][2][4][2], const Unit& u, int wr, int wc, int fr, int fq) const {
        const int row0 = u.pm * BM + wr * 64 + fr, col0 = u.pn * HALF + wc * 32 + 8 * fq;
#pragma unroll
        for (int ai = 0; ai < 2; ++ai)
#pragma unroll
            for (int m = 0; m < 4; ++m) { unsigned char* rowp = O + (size_t)(row0 + ai * HALF + m * 16) * 1024 + col0; float r[8];
#pragma unroll
                for (int n = 0; n < 2; ++n)
#pragma unroll
                    for (int j = 0; j < 4; ++j) { const float g = acc[ai][0][m][n][j], up = acc[ai][1][m][n][j]; r[4 * n + j] = g * up * __builtin_amdgcn_rcpf(1.0f + __expf(-g)); }
                int w0 = 0, w1 = 0; w0 = __builtin_amdgcn_cvt_pk_fp8_f32(r[0], r[1], w0, false); w0 = __builtin_amdgcn_cvt_pk_fp8_f32(r[2], r[3], w0, true);
                w1 = __builtin_amdgcn_cvt_pk_fp8_f32(r[4], r[5], w1, false); w1 = __builtin_amdgcn_cvt_pk_fp8_f32(r[6], r[7], w1, true);
                typedef int i32x2 __attribute__((ext_vector_type(2))); *(i32x2*)rowp = (i32x2){w0, w1}; }
    }
};

template <class Epi, class Sched, bool FP8 = false>
__device__ __forceinline__ void gemm_phase(PG8_LAS unsigned char* lds, const int KB, const Sched& S, const Epi& E, const int wave_id) {
    unsigned m_ = ~0u; asm volatile("" : "+s"(m_)); const int lane_ = (int)__builtin_amdgcn_mbcnt_hi(m_, __builtin_amdgcn_mbcnt_lo(m_, 0u));
    int wid_ = wave_id; asm volatile("" : "+s"(wid_));
    const int wid = wid_, lane = lane_, tid = wid * 64 + lane, wr = wid >> 2, wc = wid & 3, fr = lane & 15, fq = lane >> 4;
    const int nt = KB / (BK * 2);
    unsigned voffB[2]; int Rr[2], Cb[2];
#pragma unroll
    for (int i = 0; i < 2; ++i) { int R, C; stage_rc(tid * 16 + i * 8192, R, C); const int Rb = Epi::PERM ? ((R & ~31) + perm32(R & 31)) : R;
        Rr[i] = R; Cb[i] = C * 2; voffB[i] = (unsigned)(Rb * KB + C * 2); }
    const size_t kstep = (size_t)(BK * 2);
    const size_t hstep = (size_t)HALF * KB;
    const unsigned ldsw = (unsigned)wid * 1024u;
    const int aoff = lds_byte(wr * 64 + fr, fq * 8), boff = lds_byte(wc * 32 + fr, fq * 8);
#define PG8_SA(b, h) (((b) * 2 + (h)) * HTB)
#define PG8_SB(b, h) ((4 + (b) * 2 + (h)) * HTB)
#define PG8_STAGE(bufoff, gbase, voff) do { _Pragma("unroll") for (int _i = 0; _i < 2; ++_i) \
        __builtin_amdgcn_global_load_lds((const unsigned*)((const char*)(gbase) + (voff)[_i]), (PG8_LAS unsigned*)(lds + (bufoff) + ldsw + _i * 8192), 16, 0, 0); } while (0)
#define PG8_LDA(dst, b, h) do { _Pragma("unroll") for (int m = 0; m < 4; ++m) dst[m] = ldfrag2(lds + PG8_SA(b, h) + aoff + m * 2048); } while (0)
#define PG8_LDB(dst, b, h) do { _Pragma("unroll") for (int n = 0; n < 2; ++n) dst[n] = ldfrag2(lds + PG8_SB(b, h) + boff + n * 2048); } while (0)
#define PG8_MMA(ai, bj, At, Bt) do { __builtin_amdgcn_s_setprio(1); _Pragma("unroll") for (int m = 0; m < 4; ++m) _Pragma("unroll") for (int n = 0; n < 2; ++n) { \
        if constexpr (FP8) { asm volatile("v_mfma_scale_f32_16x16x128_f8f6f4 %0, %1, %2, %0, %3, %4 op_sel_hi:[0,0,0]" : "+v"(acc[ai][bj][m][n]) : "v"(Bt[n].v), "v"(At[m].v), "v"(sc_w), "v"(sc_1)); } \
        else { _Pragma("unroll") for (int k = 0; k < 2; ++k) acc[ai][bj][m][n] = __builtin_amdgcn_mfma_f32_16x16x32_bf16(fhalf(Bt[n], k), fhalf(At[m], k), acc[ai][bj][m][n], 0, 0, 0); } } __builtin_amdgcn_s_setprio(0); } while (0)
#define PG8_WAIT_V(n) asm volatile("s_waitcnt vmcnt(" #n ")" ::: "memory")
#define PG8_WAIT_L(n) asm volatile("s_waitcnt lgkmcnt(" #n ")" ::: "memory")
#define PG8_BAR __builtin_amdgcn_s_barrier()
#define PG8_SCHED __builtin_amdgcn_sched_barrier(0)
    Unit cur, nxt; int ui = 0;
    if (!S.next(0, cur)) return;
    f32x4 acc[2][2][4][2];
#pragma unroll
    for (int a = 0; a < 2; ++a)
#pragma unroll
        for (int b = 0; b < 2; ++b)
#pragma unroll
            for (int m = 0; m < 4; ++m)
#pragma unroll
                for (int n = 0; n < 2; ++n) acc[a][b][m][n] = (f32x4){0.f, 0.f, 0.f, 0.f};
    Frag At[4], B0[2], B1[2];
    int sc_w = 0x79797979, sc_1 = 0x7f7f7f7f;
    if constexpr (FP8) asm volatile("" : "+v"(sc_w), "+v"(sc_1));
    unsigned voA[2][2], voN[2][2];
    S.a_offs(cur, Rr, Cb, voA);
    const char* cA = S.a_base(cur); const char* cB = S.b_base(cur);
    PG8_STAGE(PG8_SB(0, 0), cB, voffB); PG8_STAGE(PG8_SB(0, 1), cB + hstep, voffB); PG8_STAGE(PG8_SA(0, 0), cA, voA[0]); PG8_STAGE(PG8_SA(0, 1), cA, voA[1]);
    if (wr == 1) PG8_BAR;
    PG8_WAIT_V(2); PG8_BAR;
    PG8_STAGE(PG8_SB(1, 0), cB + kstep, voffB); PG8_STAGE(PG8_SA(1, 0), cA + kstep, voA[0]); PG8_STAGE(PG8_SB(1, 1), cB + hstep + kstep, voffB);
    PG8_WAIT_V(6); PG8_BAR;
    bool has_next = S.next(ui + 1, nxt);
    const char* nA = cA; const char* nB = cB;
    if (has_next) { S.a_offs(nxt, Rr, Cb, voN); nA = S.a_base(nxt); nB = S.b_base(nxt); }
    else {
#pragma unroll
        for (int h = 0; h < 2; ++h)
#pragma unroll
            for (int i = 0; i < 2; ++i) voN[h][i] = voA[h][i];
    }
    asm volatile("" : "+v"(voN[0][0]), "+v"(voN[0][1]), "+v"(voN[1][0]), "+v"(voN[1][1]));
    for (;;) {
#pragma nounroll
        for (int t = 0; t < nt; t += 2) {
            const bool last = (t == nt - 2);
            const char* a1 = cA + (size_t)(t + 1) * kstep;
            const char* a2 = last ? nA : cA + (size_t)(t + 2) * kstep; const char* b2 = last ? nB : cB + (size_t)(t + 2) * kstep;
            const char* a3 = a2 + kstep; const char* b3 = b2 + kstep;
            unsigned vo2[2][2];
#pragma unroll
            for (int h = 0; h < 2; ++h)
#pragma unroll
                for (int i = 0; i < 2; ++i) vo2[h][i] = last ? voN[h][i] : voA[h][i];
            PG8_LDB(B0, 0, 0); PG8_LDB(B1, 0, 1); PG8_SCHED; PG8_LDA(At, 0, 0); PG8_STAGE(PG8_SA(1, 1), a1, voA[1]);
            PG8_WAIT_V(8); PG8_WAIT_L(0); PG8_BAR; PG8_MMA(0, 0, At, B0); PG8_MMA(0, 1, At, B1); PG8_BAR; PG8_SCHED;
            PG8_LDA(At, 0, 1); PG8_STAGE(PG8_SB(0, 0), b2, voffB); PG8_STAGE(PG8_SB(0, 1), b2 + hstep, voffB); PG8_STAGE(PG8_SA(0, 0), a2, vo2[0]);
            PG8_WAIT_V(8); PG8_WAIT_L(0); PG8_BAR; PG8_MMA(1, 0, At, B0); PG8_MMA(1, 1, At, B1); PG8_BAR; PG8_SCHED;
            PG8_LDB(B0, 1, 0); PG8_LDB(B1, 1, 1); PG8_SCHED; PG8_LDA(At, 1, 0); PG8_STAGE(PG8_SA(0, 1), a2, vo2[1]);
            PG8_WAIT_V(8); PG8_WAIT_L(0); PG8_BAR; PG8_MMA(0, 0, At, B0); PG8_MMA(0, 1, At, B1); PG8_BAR; PG8_SCHED;
            PG8_LDA(At, 1, 1); PG8_STAGE(PG8_SB(1, 0), b3, voffB); PG8_STAGE(PG8_SB(1, 1), b3 + hstep, voffB); PG8_STAGE(PG8_SA(1, 0), a3, vo2[0]);
            PG8_WAIT_V(8); PG8_WAIT_L(0); PG8_BAR; PG8_MMA(1, 0, At, B0); PG8_MMA(1, 1, At, B1); PG8_BAR; PG8_SCHED;
        }
        if (wr == 0) PG8_BAR;
        if constexpr (FP8) asm volatile("s_nop 15\n\ts_nop 15" ::: "memory");
        Unit nn; nn.pm = 0; nn.pn = 0; nn.e = 0; bool has_nn = false; int tokn[2][2] = {{0, 0}, {0, 0}};
        if (has_next) { has_nn = S.next(ui + 2, nn); if (has_nn) S.a_idx(nn, Rr, tokn); }
        asm volatile("" ::: "memory");
        E(acc, cur, wr, wc, fr, fq);
        if (!has_next) break;
#pragma unroll
        for (int a = 0; a < 2; ++a)
#pragma unroll
            for (int b = 0; b < 2; ++b)
#pragma unroll
                for (int m = 0; m < 4; ++m)
#pragma unroll
                    for (int n = 0; n < 2; ++n) acc[a][b][m][n] = (f32x4){0.f, 0.f, 0.f, 0.f};
        if constexpr (FP8) asm volatile("s_nop 7" ::: "memory");
        cur = nxt; cA = nA; cB = nB; ++ui;
#pragma unroll
        for (int h = 0; h < 2; ++h)
#pragma unroll
            for (int i = 0; i < 2; ++i) voA[h][i] = voN[h][i];
        has_next = has_nn;
        if (has_nn) { nxt = nn; asm volatile("" : "+v"(tokn[0][0]), "+v"(tokn[0][1]), "+v"(tokn[1][0]), "+v"(tokn[1][1])); S.a_vo(tokn, Cb, voN); nA = S.a_base(nn); nB = S.b_base(nn); }
        else { nA = cA; nB = cB; }
        asm volatile("" : "+v"(voN[0][0]), "+v"(voN[0][1]), "+v"(voN[1][0]), "+v"(voN[1][1]));
        if (wr == 1) PG8_BAR;
    }
    PG8_WAIT_V(0);
    PG8_BAR;
#undef PG8_SA
#undef PG8_SB
#undef PG8_STAGE
#undef PG8_LDA
#undef PG8_LDB
#undef PG8_MMA
#undef PG8_WAIT_V
#undef PG8_WAIT_L
#undef PG8_BAR
#undef PG8_SCHED
}
}

struct Frame {
    LAS unsigned char* lds;
    volatile LAS unsigned* MISC;
    unsigned* ctl;
    int tid, lane, wave, G, bid;
    const float *x, *g_mix, *w_in, *conv_w, *w_out, *g_ffn, *w_group, *b_group, *w_router, *b_router, *w_gate, *w_up, *w_down, *g_final;
    float* out;
    unsigned char* ws;
};
constexpr int NWAVES = 8;

__device__ __forceinline__ void tr_item(const float* W, int ldw, int k0, int n0, bf16* WT, int ldd, int drow0, float scale, LAS float* scr, int lane) {
    float v[32];
#pragma unroll
    for (int i = 0; i < 32; ++i) v[i] = W[(size_t)(k0 + 2 * i + (lane >> 5)) * ldw + n0 + (lane & 31)];
#pragma unroll
    for (int i = 0; i < 32; ++i) scr[(2 * i + (lane >> 5)) * 33 + (lane & 31)] = v[i] * scale;
    LDS_WAIT(); asm volatile("" ::: "memory");
    const int c = lane & 7;
#pragma unroll
    for (int j = 0; j < 4; ++j) { const int n = (lane >> 3) + 8 * j; const LAS float* s = scr + (8 * c) * 33 + n;
        v4u o; o.x = pk2(s[0 * 33], s[1 * 33]); o.y = pk2(s[2 * 33], s[3 * 33]); o.z = pk2(s[4 * 33], s[5 * 33]); o.w = pk2(s[6 * 33], s[7 * 33]);
        *(v4u*)(WT + (size_t)(drow0 + n) * ldd + k0 + 8 * c) = o; }
    LDS_WAIT(); asm volatile("" ::: "memory");
}
__device__ __forceinline__ void tr_item8(const float* W, int ldw, int k0, int n0, unsigned char* WT, int ldd, int drow0, float scale, LAS float* scr, int lane) {
    float v[64];
#pragma unroll
    for (int i = 0; i < 64; ++i) v[i] = W[(size_t)(k0 + 2 * i + (lane >> 5)) * ldw + n0 + (lane & 31)];
#pragma unroll
    for (int i = 0; i < 64; ++i) scr[(2 * i + (lane >> 5)) * 33 + (lane & 31)] = v[i] * scale;
    LDS_WAIT(); asm volatile("" ::: "memory");
    const int c = lane & 7;
#pragma unroll
    for (int j = 0; j < 4; ++j) { const int n = (lane >> 3) + 8 * j; const LAS float* sp = scr + (16 * c) * 33 + n; int w[4];
#pragma unroll
        for (int q = 0; q < 4; ++q) { int t = 0; t = __builtin_amdgcn_cvt_pk_fp8_f32(sp[(4 * q + 0) * 33], sp[(4 * q + 1) * 33], t, false); t = __builtin_amdgcn_cvt_pk_fp8_f32(sp[(4 * q + 2) * 33], sp[(4 * q + 3) * 33], t, true); w[q] = t; }
        *(v4u*)(WT + (size_t)(drow0 + n) * ldd + k0 + 16 * c) = (v4u){(unsigned)w[0], (unsigned)w[1], (unsigned)w[2], (unsigned)w[3]}; }
    LDS_WAIT(); asm volatile("" ::: "memory");
}
__device__ __forceinline__ unsigned pk4_fp8(float a, float b, float c, float d) { int w = 0; w = __builtin_amdgcn_cvt_pk_fp8_f32(a, b, w, false); w = __builtin_amdgcn_cvt_pk_fp8_f32(c, d, w, true); return (unsigned)w; }
__device__ __forceinline__ void norm_row_bf16(const float* xrow, const float* g, bf16* orow, unsigned char* orow8, bf16* xcopy, int lane) {
    const f32x4* xr = (const f32x4*)xrow + lane; f32x4 v[8]; float s = 0.f; v2u* xc = (v2u*)xcopy + lane;
#pragma unroll
    for (int j = 0; j < 8; ++j) { v[j] = xr[64 * j]; s += (v[j].x * v[j].x + v[j].y * v[j].y) + (v[j].z * v[j].z + v[j].w * v[j].w); xc[64 * j] = (v2u){pk2(v[j].x, v[j].y), pk2(v[j].z, v[j].w)}; }
    const float rstd = 1.0f / sqrtf(wave_sum(s, lane) * (1.0f / D) + EPS);
    const f32x4* gr = (const f32x4*)g + lane; v2u* o8 = (v2u*)orow + lane; unsigned* of8 = (unsigned*)orow8 + lane;
#pragma unroll
    for (int j = 0; j < 8; ++j) { const f32x4 gv = gr[64 * j]; const f32x4 hv = v[j] * rstd * gv; v2u o; o.x = pk2(hv.x, hv.y); o.y = pk2(hv.z, hv.w); o8[64 * j] = o; of8[64 * j] = pk4_fp8(hv.x, hv.y, hv.z, hv.w); }
}
__device__ __forceinline__ void sincos_d(double a, float& c, float& s) {
    const double twopi = 6.283185307179586476925286766559, inv = 0.15915494309189533576888376337251;
    const double r = a - twopi * __builtin_rint(a * inv), r2 = r * r;
    double ss = 0.0, cc = 0.0;
#pragma unroll
    for (int k = 12; k >= 1; --k) { ss = (ss + 1.0) * (-r2 / (double)((2 * k) * (2 * k + 1))); cc = (cc + 1.0) * (-r2 / (double)((2 * k - 1) * (2 * k))); }
    s = (float)(r * (1.0 + ss)); c = (float)(1.0 + cc);
}
constexpr int I_IN = NLAYER * 32 * 96, I_IN8 = NLAYER * 16 * 128, I_OUT = NLAYER * 32 * 64, I_G = NLAYER * NE * 16 * 32, I_D = NLAYER * NE * 8 * 64;
constexpr int NITEMS = I_IN + I_IN8 + I_OUT + 2 * I_G + I_D;
__device__ __forceinline__ int cw_vit(int qsel, int v) {
    constexpr int hIN = I_IN / 2, hIN8 = I_IN8 / 2, hG = I_G / 2, hD = I_D / 2, oG = I_IN + I_IN8 + I_OUT, oU = oG + I_G, oD = oU + I_G;
    if (qsel == 2) return v < hG ? oG + hG + v : (v < 2 * hG ? oU + hG + (v - hG) : oD + hD + (v - 2 * hG));
    if (v < hIN) return hIN + v; v -= hIN;
    if (v < hIN8) return I_IN + hIN8 + v; v -= hIN8;
    if (v < I_OUT) return I_IN + I_IN8 + v; v -= I_OUT;
    if (v < hG) return oG + v; v -= hG;
    if (v < hG) return oU + v; v -= hG;
    return oD + v;
}
__device__ __forceinline__ void conv_weights(Frame& F, int it_lo, int it_hi, int cb, int ncb, unsigned* q = nullptr, const int qsel = 1, const int maxc = 0x7fffffff) {
    LAS float* scr = (LAS float*)(F.lds + F.wave * 17408);
    const int gw = cb * NWAVES + F.wave, NGW = ncb * NWAVES, lane = F.lane;
    bf16* WIN = (bf16*)(F.ws + WS_WIN); bf16* WOUT = (bf16*)(F.ws + WS_WOUT); unsigned char* W13 = F.ws + WS_W13; unsigned char* W2 = F.ws + WS_W2;
    struct CJ { const float* src; unsigned char* dst; int ldw, ldd, fp8; float scale; };
#define CW_DECODE(it_, J) do { int r = (it_); \
        if (r < I_IN) { const int l = r / (32 * 96), q = r % (32 * 96), kb = q / 96, nb = q % 96, n0 = nb * 32, k0 = kb * 64; \
            const int dr = n0 < 1024 ? n0 : (n0 < 2048 ? 1024 + 256 * ((n0 - 1024) >> 7) + (n0 & 127) : 1024 + 256 * ((n0 - 2048) >> 7) + 128 + (n0 & 127));     \
            J.src = F.w_in + (size_t)l * D * NZ + (size_t)k0 * NZ + n0; J.ldw = NZ; J.ldd = 2 * D; J.fp8 = 0; J.scale = 1.0f; J.dst = (unsigned char*)(WIN + (size_t)l * NZ * D + (size_t)dr * D + k0); } \
        else if ((r -= I_IN) < I_IN8) { const int l = r / (16 * 128), q = r % (16 * 128), kb = q / 128, nb = q % 128, n0 = 3072 + nb * 32, k0 = kb * 128; \
            J.src = F.w_in + (size_t)l * D * NZ + (size_t)k0 * NZ + n0; J.ldw = NZ; J.ldd = D; J.fp8 = 1; J.scale = 64.0f; J.dst = F.ws + WS_WIN8 + (size_t)l * 4096 * D + (size_t)(n0 - 3072) * D + k0; } \
        else if ((r -= I_IN8) < I_OUT) { const int l = r / (32 * 64), q = r % (32 * 64), kb = q / 64, nb = q % 64, n0 = nb * 32, k0 = kb * 64; \
            J.src = F.w_out + (size_t)l * D * D + (size_t)k0 * D + n0; J.ldw = D; J.ldd = 2 * D; J.fp8 = 0; J.scale = 1.0f; J.dst = (unsigned char*)(WOUT + (size_t)l * D * D + (size_t)n0 * D + k0); } \
        else if ((r -= I_OUT) < 2 * I_G) { const int up = r >= I_G; if (up) r -= I_G; const int le = r / 512, q = r % 512, kb = q / 32, nb = q % 32, n0 = nb * 32, k0 = kb * 128; \
            J.src = (up ? F.w_up : F.w_gate) + (size_t)le * D * DE + (size_t)k0 * DE + n0; J.ldw = DE; J.ldd = D; J.fp8 = 1; J.scale = 64.0f; \
            J.dst = W13 + (size_t)le * 2048 * D + (size_t)(256 * (n0 >> 7) + (up ? 128 : 0) + (n0 & 127)) * D + k0; } \
        else { r -= 2 * I_G; const int le = r / 512, q = r % 512, kb = q / 64, nb = q % 64, n0 = nb * 32, k0 = kb * 128; \
            J.src = F.w_down + (size_t)le * DE * D + (size_t)k0 * D + n0; J.ldw = D; J.ldd = DE; J.fp8 = 1; J.scale = 64.0f; J.dst = W2 + (size_t)le * D * DE + (size_t)n0 * DE + k0; } } while (0)
#define CW_LOAD(J, v) do { const f32x4* sp_ = (const f32x4*)(J.src + (size_t)(lane >> 3) * J.ldw) + (lane & 7); \
        _Pragma("unroll") for (int i = 0; i < 8; ++i) v[i] = *(const f32x4*)((const float*)sp_ + (size_t)(8 * i) * J.ldw); \
        if (J.fp8) { _Pragma("unroll") for (int i = 8; i < 16; ++i) v[i] = *(const f32x4*)((const float*)sp_ + (size_t)(8 * i) * J.ldw); } } while (0)
#define CW_ST(i_) do { const int k_ = 8 * (i_) + (lane >> 3); LAS float* wp_ = scr + k_ * 34 + ((4 * (lane & 7) + 4 * ((i_) >> 1)) & 31); const f32x4 t_ = v_[(i_)] * sc_; \
        *(LAS f32x2*)wp_ = (f32x2){t_.x, t_.y}; *(LAS f32x2*)(wp_ + 2) = (f32x2){t_.z, t_.w}; } while (0)
#define CW_PROC(J, v) do { const f32x4* v_ = v; const float sc_ = J.scale; \
        _Pragma("unroll") for (int i = 0; i < 8; ++i) CW_ST(i); \
        if (J.fp8) { _Pragma("unroll") for (int i = 8; i < 16; ++i) CW_ST(i); } \
        LDS_WAIT(); asm volatile("" ::: "memory"); \
        { const int c = lane & 7; \
          _Pragma("unroll") for (int j = 0; j < 4; ++j) { const int n = (lane >> 3) + 8 * j; \
            if (J.fp8) { const LAS float* sp = scr + (16 * c) * 34 + ((n + 4 * c) & 31); \
                *(v4u*)(J.dst + (size_t)n * J.ldd + 16 * c) = (v4u){pk4_fp8(sp[0 * 34], sp[1 * 34], sp[2 * 34], sp[3 * 34]), pk4_fp8(sp[4 * 34], sp[5 * 34], sp[6 * 34], sp[7 * 34]), pk4_fp8(sp[8 * 34], sp[9 * 34], sp[10 * 34], sp[11 * 34]), pk4_fp8(sp[12 * 34], sp[13 * 34], sp[14 * 34], sp[15 * 34])}; } \
            else { const LAS float* sp = scr + (8 * c) * 34 + ((n + 4 * (c >> 1)) & 31); \
                *(v4u*)(J.dst + (size_t)n * J.ldd + 16 * c) = (v4u){pk2(sp[0 * 34], sp[1 * 34]), pk2(sp[2 * 34], sp[3 * 34]), pk2(sp[4 * 34], sp[5 * 34]), pk2(sp[6 * 34], sp[7 * 34])}; } } } \
        LDS_WAIT(); asm volatile("" ::: "memory"); } while (0)
    CJ ja, jb; f32x4 va[16], vb[16];
    if (q) {
        constexpr int NV2 = I_G + I_D / 2, NV1 = NITEMS - I_IN / 2 - I_IN8 / 2 - NV2, CH = 8;
        const int NV = qsel == 2 ? NV2 : NV1;
#define CW_VIT(v_) cw_vit(qsel, (v_))
        for (int nc = 0; nc < maxc; ++nc) {
            int base = 0; if (lane == 0) base = (int)__hip_atomic_fetch_add(q, (unsigned)CH, __ATOMIC_RELAXED, __HIP_MEMORY_SCOPE_AGENT);
            base = __builtin_amdgcn_readfirstlane(base);
            if (base >= NV) break;
            CW_DECODE(CW_VIT(base), ja); CW_LOAD(ja, va);
#pragma unroll 1
            for (int j = 0; j < CH; j += 2) {
                if (base + j + 1 < NV) { CW_DECODE(CW_VIT(base + j + 1), jb); CW_LOAD(jb, vb); }
                CW_PROC(ja, va);
                if (base + j + 1 >= NV) break;
                if (j + 2 < CH && base + j + 2 < NV) { CW_DECODE(CW_VIT(base + j + 2), ja); CW_LOAD(ja, va); }
                CW_PROC(jb, vb);
                if (base + j + 2 >= NV) break;
            }
        }
#undef CW_VIT
        return;
    }
    int it = it_lo + gw;
    if (it < it_hi) { CW_DECODE(it, ja); CW_LOAD(ja, va); }
    while (it < it_hi) {
        if (it + NGW < it_hi) { CW_DECODE(it + NGW, jb); CW_LOAD(jb, vb); }
        CW_PROC(ja, va);
        it += NGW; if (it >= it_hi) break;
        if (it + NGW < it_hi) { CW_DECODE(it + NGW, ja); CW_LOAD(ja, va); }
        CW_PROC(jb, vb);
        it += NGW;
    }
#undef CW_DECODE
#undef CW_LOAD
#undef CW_ST
#undef CW_PROC
}
__device__ __forceinline__ void p0_prologue(Frame& F, const bool all_weights) {
    const int gw = F.bid * NWAVES + F.wave, NGW = F.G * NWAVES;
    if (all_weights) conv_weights(F, 0, NITEMS, F.bid, F.G);
    else { conv_weights(F, 0, I_IN / 2, F.bid, F.G); conv_weights(F, I_IN, I_IN + I_IN8 / 2, F.bid, F.G); }
    { f32x2* cs = (f32x2*)(F.ws + WS_ROPE);
      for (int i = F.bid * 512 + F.tid; i < SEQ * 64; i += F.G * 512) { const int pos = i >> 6, j = i & 63;
          double inv = 1.0; const double cbase = 0.86596432336006535;
          for (int q = 0; q < j; ++q) inv *= cbase;
          const float ang = (float)pos * (float)inv; float c, s; sincos_d((double)ang, c, s); cs[i] = (f32x2){c, s}; } }
    { v4u* wr = (v4u*)(F.ws + WS_WR);
      for (int i = F.bid * 512 + F.tid; i < NLAYER * 64 * 3 * 2 * 64; i += F.G * 512) {
          const int ln = i & 63, hl = (i >> 6) & 1, q = i >> 7, nt = q % 3, s = (q / 3) % 64, l = q / 192;
          const int n = 16 * nt + (ln & 15); unsigned w[4];
#pragma unroll
          for (int jj = 0; jj < 4; ++jj) { float v[2];
#pragma unroll
              for (int e = 0; e < 2; ++e) { const int k = 32 * s + 8 * (ln >> 4) + 2 * jj + e;
                  float val = 0.f; if (n < 4) val = F.w_group[((size_t)l * D + k) * 4 + n]; else if (n < 36) val = F.w_router[((size_t)l * D + k) * 32 + (n - 4)];
                  val *= F.g_ffn[l * D + k]; const float hi = bf2f((bf16)f2bf(val)); v[e] = hl ? (val - hi) : val; }
              w[jj] = pk2(v[0], v[1]); }
          wr[i] = (v4u){w[0], w[1], w[2], w[3]}; } }
    { bf16* H = (bf16*)(F.ws + WS_H);
      bf16* X1 = (bf16*)(F.ws + WS_X1);
      const f32x4* gr = (const f32x4*)F.g_mix + F.lane;
      for (int m = gw; m < T; m += 2 * NGW) {
          f32x4 v[2][8]; float ss[2] = {0.f, 0.f};
#pragma unroll
          for (int r = 0; r < 2; ++r) { const f32x4* xr = (const f32x4*)(F.x + (size_t)(m + r * NGW) * D) + F.lane;
#pragma unroll
              for (int j = 0; j < 8; ++j) v[r][j] = xr[64 * j]; }
#pragma unroll
          for (int r = 0; r < 2; ++r) { const size_t row = (size_t)(m + r * NGW); v2u* xc = (v2u*)(X1 + row * D) + F.lane; v2u* o8 = (v2u*)(H + row * D) + F.lane; unsigned* of8 = (unsigned*)(F.ws + WS_H8 + row * D) + F.lane;
#pragma unroll
              for (int j = 0; j < 8; ++j) { const f32x4 t = v[r][j]; ss[r] += (t.x * t.x + t.y * t.y) + (t.z * t.z + t.w * t.w); xc[64 * j] = (v2u){pk2(t.x, t.y), pk2(t.z, t.w)}; }
              const float rstd = __builtin_amdgcn_rsqf(wave_sum(ss[r], F.lane) * (1.0f / D) + EPS);
#pragma unroll
              for (int j = 0; j < 8; ++j) { const f32x4 gv = gr[64 * j]; const f32x4 hv = v[r][j] * rstd * gv; v2u o; o.x = pk2(hv.x, hv.y); o.y = pk2(hv.z, hv.w); o8[64 * j] = o; of8[64 * j] = pk4_fp8(hv.x, hv.y, hv.z, hv.w); } } } }
}

typedef short s16x4 __attribute__((ext_vector_type(4)));
__device__ __forceinline__ f32x16 mfma32(bf16x8 a, bf16x8 b, f32x16 c) { return __builtin_amdgcn_mfma_f32_32x32x16_bf16(a, b, c, 0, 0, 0); }
constexpr int PR = 272, PT = 320;
constexpr int RQ = 0, RK = RQ + 64 * PR, RKD = RK + 64 * PR, RV = RKD + 64 * PT, RRT = RV + 64 * PT, RSF = RRT + 128 * PR, RSQ = RSF + 8192, R_END = RSQ + 1024;
static_assert(R_END <= MISC_OFF, "retention LDS");
__device__ __forceinline__ s16x4 trr(const LAS unsigned char* a) { return __builtin_amdgcn_ds_read_tr16_b64_v4i16((LAS s16x4*)a); }
__device__ __forceinline__ bf16x8 cat8(s16x4 a, s16x4 b) { return (bf16x8){a.x, a.y, a.z, a.w, b.x, b.y, b.z, b.w}; }
struct RetPre { v4u q1, q2, k1, k2, v1, v2; f32x4 cs[4]; };
__device__ __forceinline__ void ret_load(RetPre& P, const bf16* zr, const f32x2* csrow, int h, int part) {
    const int j0 = 8 * part;
    P.q1 = *(const v4u*)(zr + 3072 + HD * h + j0); P.q2 = *(const v4u*)(zr + 3072 + HD * h + 64 + j0);
    P.k1 = *(const v4u*)(zr + 4096 + HD * h + j0); P.k2 = *(const v4u*)(zr + 4096 + HD * h + 64 + j0);
    P.v1 = *(const v4u*)(zr + 5120 + HD * h + 16 * part); P.v2 = *(const v4u*)(zr + 5120 + HD * h + 16 * part + 8);
    (void)csrow;
}
__device__ __forceinline__ void ret_load_cs(RetPre& P, const f32x2* csrow, int part) {
    const f32x4* csp = (const f32x4*)(csrow + 8 * part);
#pragma unroll
    for (int p = 0; p < 4; ++p) P.cs[p] = csp[p];
}
__device__ __forceinline__ void ret_write(const RetPre& P, LAS unsigned char* wr, LAS unsigned char* wt, float kd) {
    float ql[8], qh[8], kl[8], kh[8];
#pragma unroll
    for (int p = 0; p < 4; ++p) { const f32x4 c4 = P.cs[p];
#pragma unroll
        for (int e = 0; e < 2; ++e) { const int jj = 2 * p + e; const float c = e ? c4.z : c4.x, s = e ? c4.w : c4.y;
            const float a = e ? bfhi(P.q1[p]) : bflo(P.q1[p]), bb = e ? bfhi(P.q2[p]) : bflo(P.q2[p]);
            ql[jj] = a * c - bb * s; qh[jj] = bb * c + a * s;
            const float ka = e ? bfhi(P.k1[p]) : bflo(P.k1[p]), kb = e ? bfhi(P.k2[p]) : bflo(P.k2[p]);
            kl[jj] = (ka * c - kb * s) * 0.08838834764831845f; kh[jj] = (kb * c + ka * s) * 0.08838834764831845f; } }
    *(LAS v4u*)(wr + RQ) = (v4u){pk2(ql[0], ql[1]), pk2(ql[2], ql[3]), pk2(ql[4], ql[5]), pk2(ql[6], ql[7])};
    *(LAS v4u*)(wr + RQ + 128) = (v4u){pk2(qh[0], qh[1]), pk2(qh[2], qh[3]), pk2(qh[4], qh[5]), pk2(qh[6], qh[7])};
    *(LAS v4u*)(wr + RK) = (v4u){pk2(kl[0], kl[1]), pk2(kl[2], kl[3]), pk2(kl[4], kl[5]), pk2(kl[6], kl[7])};
    *(LAS v4u*)(wr + RK + 128) = (v4u){pk2(kh[0], kh[1]), pk2(kh[2], kh[3]), pk2(kh[4], kh[5]), pk2(kh[6], kh[7])};
    *(LAS v4u*)(wt + RKD) = (v4u){pk2(kl[0] * kd, kl[1] * kd), pk2(kl[2] * kd, kl[3] * kd), pk2(kl[4] * kd, kl[5] * kd), pk2(kl[6] * kd, kl[7] * kd)};
    *(LAS v4u*)(wt + RKD + 128) = (v4u){pk2(kh[0] * kd, kh[1] * kd), pk2(kh[2] * kd, kh[3] * kd), pk2(kh[4] * kd, kh[5] * kd), pk2(kh[6] * kd, kh[7] * kd)};
}
__device__ __forceinline__ void retention_unit(Frame& F, const bf16* Z, bf16* Y, int b, int h) {
    const int tid = F.tid, lane = F.lane, wid = F.wave, l31 = lane & 31, lh = lane >> 5;
    LAS unsigned char* L = F.lds;
    const float xg = __builtin_amdgcn_exp2f(-(float)(5 + h));
    const float lng = -(xg + xg * xg * 0.5f + xg * xg * xg * (1.0f / 3.0f) + xg * xg * xg * xg * 0.25f + xg * xg * xg * xg * xg * 0.2f + xg * xg * xg * xg * xg * xg * (1.0f / 6.0f));
    const float lg2 = lng * 1.4426950408889634f;
    const float cd = __builtin_amdgcn_exp2f(lg2 * 64.0f);
    const f32x2* CS = (const f32x2*)(F.ws + WS_ROPE);
    const int li = tid >> 3, part = tid & 7;
    const float kd = __builtin_amdgcn_exp2f(lg2 * (float)(63 - li));
    LAS unsigned char* const wr = L + li * PR + 16 * part; LAS unsigned char* const wt = L + li * PT + 16 * part; LAS unsigned char* const wv = L + RV + li * PT + 32 * part;
    const int ote = wid >> 1, oti = wid & 1;
    const float qdec = __builtin_amdgcn_exp2f(lg2 * (float)(32 * oti + l31 + 1));
    const LAS unsigned char* const rrow = L + l31 * PR + 16 * lh;
    const int q4 = (lane & 15) >> 2, p4 = lane & 3, blk = (lane >> 4) & 1;
    const LAS unsigned char* const tr8 = L + (q4 + 8 * lh) * PT + 32 * blk + 8 * p4;
    const LAS unsigned char* const tr4 = L + (q4 + 4 * lh) * PT + 32 * blk + 8 * p4;
    f32x16 st[4];
#pragma unroll
    for (int t = 0; t < 4; ++t)
#pragma unroll
        for (int r = 0; r < 16; ++r) st[t][r] = 0.f;
    const bf16* zbase = Z + (size_t)(b * SEQ) * NZ;
    RetPre P;
    ret_load(P, zbase + (size_t)li * NZ, CS + (size_t)li * 64, h, part); ret_load_cs(P, CS + (size_t)li * 64, part);
    ret_write(P, wr, wt, kd); *(LAS v4u*)(wv) = P.v1; *(LAS v4u*)(wv + 16) = P.v2;
    ret_load(P, zbase + (size_t)(CHUNK + li) * NZ, CS + (size_t)(CHUNK + li) * 64, h, part);
    { int lm = lane; asm volatile("" : "+v"(lm) :: "memory");
      if (wid < 4) { const int tj = wid >> 1, ti = wid & 1, l31m = lm & 31, lhm = lm >> 5;
#pragma unroll
        for (int r = 0; r < 16; ++r) { const int j = 32 * tj + (r & 3) + 8 * (r >> 2) + 4 * lhm, i = 32 * ti + l31m; st[0][r] = __builtin_amdgcn_exp2f(lg2 * (float)(i > j ? i - j : j - i)); } } }
    unsigned op[8]; v2u gz[4];
#define RET_FINALIZE(tq) do { const f32x4 q4v = *(const LAS f32x4*)(L + RSQ + (32 * oti + l31) * 16); \
          const float rs = __builtin_amdgcn_rsqf(((q4v.x + q4v.y) + (q4v.z + q4v.w)) * (1.0f / HD) + EPS); \
          bf16* yp = Y + (size_t)((tq) + 32 * oti + l31) * D + 1024 + HD * h + 32 * ote + 4 * lh; \
          _Pragma("unroll") for (int g = 0; g < 4; ++g) { float o4[4]; \
              _Pragma("unroll") for (int e = 0; e < 4; ++e) { const unsigned gw = e < 2 ? gz[g].x : gz[g].y; const float gv = (e & 1) ? bfhi(gw) : bflo(gw); const unsigned ow = op[2 * g + (e >> 1)]; const float ov = (e & 1) ? bfhi(ow) : bflo(ow); o4[e] = ov * rs * gv * __builtin_amdgcn_rcpf(1.0f + __expf(-gv)); } \
              *(v2u*)(yp + 8 * g) = (v2u){pk2(o4[0], o4[1]), pk2(o4[2], o4[3])}; } } while (0)
    __syncthreads();
    for (int n = 0; n < SEQ / CHUNK; ++n) {
        const int t0 = b * SEQ + n * CHUNK;
        if (n + 1 < SEQ / CHUNK) ret_load_cs(P, CS + (size_t)((n + 1) * CHUNK + li) * 64, part);
        if (wid < 4) {
            const int tj = wid >> 1, ti = wid & 1; f32x16 x;
            const LAS unsigned char* ka = rrow + RK + tj * (32 * PR); const LAS unsigned char* qa = rrow + RQ + ti * (32 * PR);
#pragma unroll
            for (int r = 0; r < 16; ++r) x[r] = 0.f;
#pragma unroll
            for (int s = 0; s < 8; ++s) x = mfma32(*(const LAS bf16x8*)(ka + 32 * s), *(const LAS bf16x8*)(qa + 32 * s), x);
#pragma unroll
            for (int s = 0; s < 2; ++s) { v4u f;
                f.x = pk2(x[8 * s + 0] * st[0][8 * s + 0], x[8 * s + 1] * st[0][8 * s + 1]); f.y = pk2(x[8 * s + 2] * st[0][8 * s + 2], x[8 * s + 3] * st[0][8 * s + 3]);
                f.z = pk2(x[8 * s + 4] * st[0][8 * s + 4], x[8 * s + 5] * st[0][8 * s + 5]); f.w = pk2(x[8 * s + 6] * st[0][8 * s + 6], x[8 * s + 7] * st[0][8 * s + 7]);
                *(LAS v4u*)(L + RSF + ((wid * 2 + s) * 64 + lane) * 16) = f; }
        } else {
            const int te = wid - 4;
            LAS unsigned char* rtw = L + RRT + (32 * te + l31) * PR + 8 * lh;
#pragma unroll
            for (int td = 0; td < 4; ++td)
#pragma unroll
                for (int g = 0; g < 4; ++g) { v2u w; w.x = pk2(st[td][4 * g + 0], st[td][4 * g + 1]); w.y = pk2(st[td][4 * g + 2], st[td][4 * g + 3]);
                    *(LAS v2u*)(rtw + 64 * td + 16 * g) = w; }
#pragma unroll
            for (int td = 0; td < 4; ++td)
#pragma unroll
                for (int r = 0; r < 16; ++r) st[td][r] *= cd;
            const LAS unsigned char* va = tr8 + RV + 64 * te; const LAS unsigned char* kda = tr8 + RKD;
#pragma unroll
            for (int s = 0; s < 4; ++s) { const bf16x8 bv = cat8(trr(va + (16 * s) * PT), trr(va + (16 * s + 4) * PT));
#pragma unroll
                for (int td = 0; td < 4; ++td) st[td] = mfma32(cat8(trr(kda + (16 * s) * PT + 64 * td), trr(kda + (16 * s + 4) * PT + 64 * td)), bv, st[td]); }
        }
        if (n > 0) RET_FINALIZE(t0 - CHUNK);
        __syncthreads();
        f32x16 oi, oc;
#pragma unroll
        for (int r = 0; r < 16; ++r) { oi[r] = 0.f; oc[r] = 0.f; }
        { const LAS unsigned char* va = tr4 + RV + 64 * ote; const LAS unsigned char* sf = L + RSF + (oti * 2 * 64 + lane) * 16;
#pragma unroll
          for (int tj = 0; tj < 2; ++tj)
#pragma unroll
            for (int s = 0; s < 2; ++s) { const bf16x8 xb = *(const LAS bf16x8*)(sf + (tj * 2 * 2 + s) * 1024);
                oi = mfma32(cat8(trr(va + (32 * tj + 16 * s) * PT), trr(va + (32 * tj + 16 * s + 8) * PT)), xb, oi); } }
        { const LAS unsigned char* ra = rrow + RRT + ote * (32 * PR); const LAS unsigned char* qa = rrow + RQ + oti * (32 * PR);
#pragma unroll
          for (int s = 0; s < 8; ++s) oc = mfma32(*(const LAS bf16x8*)(ra + 32 * s), *(const LAS bf16x8*)(qa + 32 * s), oc); }
        float sq = 0.f;
#pragma unroll
        for (int r = 0; r < 16; ++r) { oi[r] += qdec * oc[r]; sq += oi[r] * oi[r]; }
        sq += shx(sq, 32, lane);
        if (lane < 32) *(LAS float*)(L + RSQ + ((32 * oti + l31) * 4 + ote) * 4) = sq;
#pragma unroll
        for (int r = 0; r < 8; ++r) op[r] = pk2(oi[2 * r], oi[2 * r + 1]);
        __syncthreads();
        { const bf16* gp = Z + (size_t)(t0 + 32 * oti + l31) * NZ + 6144 + HD * h + 32 * ote + 4 * lh;
#pragma unroll
          for (int g = 0; g < 4; ++g) gz[g] = *(const v2u*)(gp + 8 * g); }
        if (n + 1 < SEQ / CHUNK) { ret_write(P, wr, wt, kd); *(LAS v4u*)(wv) = P.v1; *(LAS v4u*)(wv + 16) = P.v2; }
        if (n + 2 < SEQ / CHUNK) ret_load(P, zbase + (size_t)((n + 2) * CHUNK + li) * NZ, CS + (size_t)((n + 2) * CHUNK + li) * 64, h, part);
        __syncthreads();
    }
    RET_FINALIZE(b * SEQ + SEQ - CHUNK);
#undef RET_FINALIZE
}
__device__ __forceinline__ void conv_items(Frame& F, int l, const bf16* Z, bf16* Y, int cb, int ncb) {
    const float* cw = F.conv_w + (size_t)l * 3 * 1024;
    for (int it = cb * 512 + F.tid; it < (T / 16) * 128; it += ncb * 512) {
        const int tb = (it >> 7) * 16, c0 = 8 * (it & 127);
        float w[3][8];
#pragma unroll
        for (int k = 0; k < 3; ++k) { const f32x4 a = *(const f32x4*)(cw + k * 1024 + c0), b2 = *(const f32x4*)(cw + k * 1024 + c0 + 4);
            w[k][0] = a.x; w[k][1] = a.y; w[k][2] = a.z; w[k][3] = a.w; w[k][4] = b2.x; w[k][5] = b2.y; w[k][6] = b2.z; w[k][7] = b2.w; }
        float u1[8], u2[8];
#pragma unroll
        for (int p = 0; p < 8; ++p) { u1[p] = 0.f; u2[p] = 0.f; }
        if ((tb & (SEQ - 1)) != 0) {
#pragma unroll
            for (int d = 1; d <= 2; ++d) { const bf16* zr = Z + (size_t)(tb - d) * NZ; const v4u ug = *(const v4u*)(zr + 1024 + c0);
#pragma unroll
                for (int p = 0; p < 4; ++p) { const float lo = bflo(ug[p]), hi = bfhi(ug[p]); if (d == 1) { u1[2 * p] = lo; u1[2 * p + 1] = hi; } else { u2[2 * p] = lo; u2[2 * p + 1] = hi; } } }
        }
#pragma unroll 4
        for (int tt = 0; tt < 16; ++tt) { const bf16* zr = Z + (size_t)(tb + tt) * NZ;
            const v4u bg = *(const v4u*)(zr + c0), ug = *(const v4u*)(zr + 1024 + c0);
            float u0[8], o[8];
#pragma unroll
            for (int p = 0; p < 4; ++p) { u0[2 * p] = bflo(ug[p]); u0[2 * p + 1] = bfhi(ug[p]); }
#pragma unroll
            for (int p = 0; p < 8; ++p) { const float bgv = (p & 1) ? bfhi(bg[p >> 1]) : bflo(bg[p >> 1]); o[p] = bgv * (w[0][p] * u2[p] + w[1][p] * u1[p] + w[2][p] * u0[p]); u2[p] = u1[p]; u1[p] = u0[p]; }
            *(v4u*)(Y + (size_t)(tb + tt) * D + c0) = (v4u){pk2(o[0], o[1]), pk2(o[2], o[3]), pk2(o[4], o[5]), pk2(o[6], o[7])}; }
    }
}

__device__ __forceinline__ void router_phase(Frame& F, int l, int cw) {
    const int tid = F.tid, lane = F.lane, wid = F.wave, r16 = lane & 15, g4 = lane >> 4;
    LAS unsigned char* L = F.lds;
    LAS float* part = (LAS float*)L;
    LAS int* sel = (LAS int*)(L + 50688); LAS int* hist = (LAS int*)(L + 53248); LAS int* baseS = (LAS int*)(L + 53376); LAS int* rank = (LAS int*)(L + 53760);
    const bf16* X1 = (const bf16*)(F.ws + WS_X1); unsigned char* H8 = F.ws + WS_H8;
    const v4u* WR = (const v4u*)(F.ws + WS_WR) + (size_t)l * (64 * 3 * 2 * 64);
    const float* gff = F.g_ffn + l * D;
    int* list = (int*)(F.ws + WS_LIST); i32x4* info = (i32x4*)(F.ws + WS_INFO);
    unsigned* cntg = F.ctl + cw + 32 * l;
    LAS float* gffL = (LAS float*)(L + 61440); LAS float* lgA = (LAS float*)(L + 69632); LAS float* ssqA = (LAS float*)(L + 94208);
    *(LAS f32x4*)(gffL + 4 * tid) = *(const f32x4*)(gff + 4 * tid);
    for (int grp = F.bid; grp < T / 128; grp += F.G) {
        { int lh_ = lane; asm volatile("" : "+v"(lh_)); if (wid == 0 && lh_ < 32) hist[lh_] = 0; }
#pragma unroll 1
        for (int si = 0; si < 4; ++si) {
            const int r0 = grp * 128 + si * 32;
            LAS float* ssqs = ssqA + si * 256; LAS float* lgs = lgA + si * (32 * 48);
            v4u xb[2][8];
            int ln1 = lane; asm volatile("" : "+v"(ln1));
#pragma unroll
            for (int f = 0; f < 2; ++f) { const bf16* xr = X1 + (size_t)(r0 + 16 * f + (ln1 & 15)) * D + 256 * wid + 8 * (ln1 >> 4);
#pragma unroll
                for (int ks = 0; ks < 8; ++ks) xb[f][ks] = *(const v4u*)(xr + 32 * ks); }
            f32x4 acc[2][3]; float ss[2] = {0.f, 0.f};
#pragma unroll
            for (int f = 0; f < 2; ++f)
#pragma unroll
                for (int nt = 0; nt < 3; ++nt) acc[f][nt] = (f32x4){0.f, 0.f, 0.f, 0.f};
            v4u wfa[8][3];
#pragma unroll
            for (int kb = 0; kb < 8; ++kb) { const v4u* wp = WR + ((size_t)((8 * wid + kb) * 3) * 2) * 64 + ln1;
#pragma unroll
                for (int nt = 0; nt < 3; ++nt) wfa[kb][nt] = wp[nt * 128]; }
            asm volatile("" ::: "memory");
#pragma unroll
            for (int kb = 0; kb < 8; ++kb) {
                v4u wf[1][6];
#pragma unroll
                for (int nt = 0; nt < 3; ++nt) wf[0][nt * 2] = wfa[kb][nt];
#pragma unroll
                for (int k4 = 0; k4 < 1; ++k4) { const int ks = kb + k4;
#pragma unroll
                    for (int f = 0; f < 2; ++f) { const bf16x8 ah = __builtin_bit_cast(bf16x8, xb[f][ks]);
#pragma unroll
                        for (int p = 0; p < 4; ++p) { const float lo = bflo(xb[f][ks][p]), hi = bfhi(xb[f][ks][p]); ss[f] += lo * lo + hi * hi; }
#pragma unroll
                        for (int nt = 0; nt < 3; ++nt) { const bf16x8 bh = __builtin_bit_cast(bf16x8, wf[k4][nt * 2 + 0]);
                            acc[f][nt] = __builtin_amdgcn_mfma_f32_16x16x32_bf16(ah, bh, acc[f][nt], 0, 0, 0); } } }
            }
#pragma unroll
            for (int f = 0; f < 2; ++f) {
#pragma unroll
                for (int nt = 0; nt < 3; ++nt)
#pragma unroll
                    for (int rg = 0; rg < 4; ++rg) part[(wid * 32 + 16 * f + 4 * g4 + rg) * 48 + 16 * nt + r16] = acc[f][nt][rg];
                float q = ss[f]; q += shx(q, 16, lane); q += shx(q, 32, lane);
                if (lane < 16) ssqs[wid * 32 + 16 * f + lane] = q; }
            __syncthreads();
            int ln2 = lane; asm volatile("" : "+v"(ln2));
            const int r16 = ln2 & 15, g4 = ln2 >> 4, tid = wid * 64 + ln2;
#pragma unroll
            for (int f = 0; f < 2; ++f) { float q = 0.f;
#pragma unroll
              for (int w = 0; w < 8; ++w) q += ssqs[w * 32 + 16 * f + r16];
              const float rstd = __builtin_amdgcn_rsqf(q * (1.0f / D) + EPS); unsigned char* hr = H8 + (size_t)(r0 + 16 * f + r16) * D + 256 * wid + 8 * g4; const LAS float* gp = gffL + 256 * wid + 8 * g4;
#pragma unroll
              for (int ks = 0; ks < 8; ++ks) { const f32x4 g0 = *(const LAS f32x4*)(gp + 32 * ks), g1 = *(const LAS f32x4*)(gp + 32 * ks + 4); const v4u xx = xb[f][ks];
                  const f32x4 a = (f32x4){bflo(xx.x), bfhi(xx.x), bflo(xx.y), bfhi(xx.y)} * rstd * g0, b2 = (f32x4){bflo(xx.z), bfhi(xx.z), bflo(xx.w), bfhi(xx.w)} * rstd * g1;
                  *(v2u*)(hr + 32 * ks) = (v2u){pk4_fp8(a.x, a.y, a.z, a.w), pk4_fp8(b2.x, b2.y, b2.z, b2.w)}; } }
            for (int idx = tid; idx < 32 * 48; idx += 512) { const int row = idx / 48, n = idx - row * 48; float a = 0.f;
#pragma unroll
                for (int w = 0; w < 8; ++w) a += part[(w * 32 + row) * 48 + n];
                lgs[idx] = a; }
            __syncthreads();
        }
        int lx = lane; asm volatile("" : "+v"(lx)); const int ts = wid * 64 + lx;
        if (ts < 128) {
                const int tid = ts, si = tid >> 5, tr = tid & 31; const LAS float* ssqs = ssqA + si * 256;
                float q = 0.f;
#pragma unroll
                for (int w = 0; w < 8; ++w) q += ssqs[w * 32 + tr];
                const float rstd = 1.0f / sqrtf(q * (1.0f / D) + EPS);
                const LAS float* lg = lgA + tid * 48; const float* bg = F.b_group + l * 4; const float* br = F.b_router + l * 32;
                int gs = 0; float gm = lg[0] * rstd + bg[0];
#pragma unroll
                for (int n = 1; n < 4; ++n) { const float v = lg[n] * rstd + bg[n]; if (v > gm) { gm = v; gs = n; } }
                float den = 0.f;
#pragma unroll
                for (int n = 0; n < 4; ++n) den += __expf(lg[n] * rstd + bg[n] - gm);
                const float pg = 1.0f / den;
                int i1 = 0; float m1 = lg[4 + 8 * gs] * rstd + br[8 * gs];
#pragma unroll
                for (int n = 1; n < 8; ++n) { const float v = lg[4 + 8 * gs + n] * rstd + br[8 * gs + n]; if (v > m1) { m1 = v; i1 = n; } }
                int i2 = -1; float m2 = 0.f;
#pragma unroll
                for (int n = 0; n < 8; ++n) { const float v = lg[4 + 8 * gs + n] * rstd + br[8 * gs + n]; if (n != i1 && (i2 < 0 || v > m2)) { m2 = v; i2 = n; } }
                const float ex = __expf(m2 - m1), s1 = 1.0f / (1.0f + ex), s2 = ex / (1.0f + ex);
                const int tl = tid;
                sel[tl * 4 + 0] = gs * 8 + i1; sel[tl * 4 + 1] = gs * 8 + i2; sel[tl * 4 + 2] = __builtin_bit_cast(int, pg * s1); sel[tl * 4 + 3] = __builtin_bit_cast(int, pg * s2);
        }
        __syncthreads();
        int ly = lane; asm volatile("" : "+v"(ly)); const int td = wid * 64 + ly;
        int e_my = 0;
        if (td < 256) { e_my = sel[(td >> 1) * 4 + (td & 1)]; rank[td] = atomicAdd((int*)&hist[e_my], 1); }
        __syncthreads();
        if (td < 32) baseS[td] = (int)xb_add(cntg + td, (unsigned)hist[td]);
        __syncthreads();
        if (td < 256) { const int tok = grp * 128 + (td >> 1), slot = baseS[e_my] + rank[td];
            list[(size_t)e_my * T + slot] = tok;
            int* ip = (int*)(info + tok); ip[td & 1] = (e_my << 16) | slot; ip[2 + (td & 1)] = sel[(td >> 1) * 4 + 2 + (td & 1)]; }
        __syncthreads();
    }
}
__device__ __forceinline__ void moe_tables(Frame& F, int l) {
    LAS int* tstart = (LAS int*)(F.MISC + MW_TSTART); LAS int* cnt = (LAS int*)(F.MISC + MW_CNT); LAS int* tile_e = (LAS int*)(F.MISC + MW_TILE);
    __syncthreads();
    if (F.tid < 32) cnt[F.tid] = (int)xb_ld(F.ctl + CW_CNT + 32 * l + F.tid);
    __syncthreads();
    if (F.tid == 0) { int a = 0; for (int e = 0; e < NE; ++e) { tstart[e] = a; int c = cnt[e]; c = c < 0 ? 0 : (c > T ? T : c); a += (c + 255) >> 8; } tstart[NE] = a; }
    __syncthreads();
    for (int rt = F.tid; rt < MAXTILES + 8; rt += 512) { int e = 0; for (int q = 1; q < NE; ++q) if (tstart[q] <= rt) e = q; tile_e[rt] = e; }
    __syncthreads();
}
__device__ __forceinline__ void combine_phase(Frame& F, int l) {
    const LAS int* tstart = (const LAS int*)(F.MISC + MW_TSTART);
    const int gw = F.bid * NWAVES + F.wave, NGW = F.G * NWAVES, lane = F.lane;
    bf16* X1 = (bf16*)(F.ws + WS_X1); const unsigned char* YB = F.ws + WS_YB; bf16* H = (bf16*)(F.ws + WS_H);
    const i32x4* info = (const i32x4*)(F.ws + WS_INFO);
    const float* g = (l + 1 < NLAYER) ? F.g_mix + (l + 1) * D : F.g_final;
    const f32x4* gr = (const f32x4*)g + lane;
    i32x4 infn[2]; infn[0] = info[gw]; infn[1] = info[gw + NGW];
    for (int t = gw; t < T; t += 2 * NGW) {
        i32x4 inf[2]; inf[0] = infn[0]; inf[1] = infn[1];
        if (t + 2 * NGW < T) { infn[0] = info[t + 2 * NGW]; infn[1] = info[t + 3 * NGW]; }
        v2u xq[2][8]; unsigned ya[2][8], yb[2][8]; float wa[2], wb[2];
#pragma unroll
        for (int r = 0; r < 2; ++r) { const int tt = t + r * NGW;
            const int ra = 256 * tstart[inf[r].x >> 16] + (inf[r].x & 0xffff), rb = 256 * tstart[inf[r].y >> 16] + (inf[r].y & 0xffff);
            const int wai = inf[r].z, wbi = inf[r].w; wa[r] = __int_as_float(wai); wb[r] = __int_as_float(wbi);
            const v2u* xr = (const v2u*)(X1 + (size_t)tt * D) + lane; const unsigned* pa = (const unsigned*)(YB + (size_t)ra * D) + lane; const unsigned* pb = (const unsigned*)(YB + (size_t)rb * D) + lane;
#pragma unroll
            for (int j = 0; j < 8; ++j) { xq[r][j] = xr[64 * j]; ya[r][j] = pa[64 * j]; yb[r][j] = pb[64 * j]; } }
#pragma unroll
        for (int r = 0; r < 2; ++r) { const int tt = t + r * NGW; f32x4 v[8]; float s = 0.f;
#pragma unroll
            for (int j = 0; j < 8; ++j) { const f32x4 xv = (f32x4){bflo(xq[r][j].x), bfhi(xq[r][j].x), bflo(xq[r][j].y), bfhi(xq[r][j].y)}; const unsigned a = ya[r][j], b2 = yb[r][j];
                const f32x2 a01 = __builtin_amdgcn_cvt_pk_f32_fp8((int)a, false), a23 = __builtin_amdgcn_cvt_pk_f32_fp8((int)a, true), b01 = __builtin_amdgcn_cvt_pk_f32_fp8((int)b2, false), b23 = __builtin_amdgcn_cvt_pk_f32_fp8((int)b2, true);
                v[j].x = xv.x + wa[r] * a01.x + wb[r] * b01.x; v[j].y = xv.y + wa[r] * a01.y + wb[r] * b01.y; v[j].z = xv.z + wa[r] * a23.x + wb[r] * b23.x; v[j].w = xv.w + wa[r] * a23.y + wb[r] * b23.y;
                s += (v[j].x * v[j].x + v[j].y * v[j].y) + (v[j].z * v[j].z + v[j].w * v[j].w); }
            const float rstd = 1.0f / sqrtf(wave_sum(s, lane) * (1.0f / D) + EPS);
            if (l + 1 < NLAYER) { v2u* xo = (v2u*)(X1 + (size_t)tt * D) + lane; v2u* ho = (v2u*)(H + (size_t)tt * D) + lane; unsigned* ho8 = (unsigned*)(F.ws + WS_H8 + (size_t)tt * D) + lane;
#pragma unroll
                for (int j = 0; j < 8; ++j) { xo[64 * j] = (v2u){pk2(v[j].x, v[j].y), pk2(v[j].z, v[j].w)}; const f32x4 gv = gr[64 * j]; const f32x4 hv = v[j] * rstd * gv; v2u o; o.x = pk2(hv.x, hv.y); o.y = pk2(hv.z, hv.w); ho[64 * j] = o; ho8[64 * j] = pk4_fp8(hv.x, hv.y, hv.z, hv.w); } }
            else { f32x4* oo = (f32x4*)(F.out + (size_t)tt * D) + lane;
#pragma unroll
                for (int j = 0; j < 8; ++j) { const f32x4 gv = gr[64 * j]; oo[64 * j] = v[j] * rstd * gv; } } }
    }
}

struct Args { const float* in[14]; float* out; unsigned char* ws; int ph_lo, ph_hi; };
__global__ void __launch_bounds__(NWAVES * 64, 2) mk_fwd(Args args) {
    extern __shared__ __attribute__((aligned(16))) unsigned char lds[];
    Frame F;
    F.lds = (LAS unsigned char*)lds; F.MISC = (volatile LAS unsigned*)(F.lds + MISC_OFF);
    F.tid = threadIdx.x; F.lane = F.tid & 63; F.wave = __builtin_amdgcn_readfirstlane(F.tid >> 6); F.G = gridDim.x; F.bid = blockIdx.x;
    F.ws = args.ws; F.ctl = (unsigned*)(args.ws + WS_CTL); F.out = args.out;
    F.x = args.in[0]; F.g_mix = args.in[1]; F.w_in = args.in[2]; F.conv_w = args.in[3]; F.w_out = args.in[4]; F.g_ffn = args.in[5]; F.w_group = args.in[6]; F.b_group = args.in[7];
    F.w_router = args.in[8]; F.b_router = args.in[9]; F.w_gate = args.in[10]; F.w_up = args.in[11]; F.w_down = args.in[12]; F.g_final = args.in[13];
    for (int u = F.tid; u < (LDS_BYTES - MISC_OFF) / 4; u += NWAVES * 64) ((LAS unsigned*)(F.lds + MISC_OFF))[u] = 0u;
    __syncthreads();
    XcdBarrier bar; bar.bar = F.ctl + CW_BAR; bar.x = 0; bar.st = nullptr;
#if !MK_PER_PHASE
    bar = xcd_barrier_post(F.ctl + CW_BAR, F.MISC + MW_BAR);
#endif
    const int lo = args.ph_lo, hi = args.ph_hi;
#define REFRESH() do { unsigned m_ = ~0u; asm volatile("" : "+s"(m_)); int l_ = (int)__builtin_amdgcn_mbcnt_hi(m_, __builtin_amdgcn_mbcnt_lo(m_, 0u)); F.lane = l_; F.tid = F.wave * 64 + l_; } while (0)
#define IN(k) (!MK_PER_PHASE || (lo <= (k) && (k) < hi))
#define DUP(k) ((DUP_MASK >> (k)) & 1)
#define SEAM(k) do { if (IN(k) && IN((k) + 1)) xcd_barrier(bar); } while (0)
    bf16* Hb = (bf16*)(F.ws + WS_H); bf16* Zb = (bf16*)(F.ws + WS_Z); bf16* Yb = (bf16*)(F.ws + WS_Y); bf16* X1 = (bf16*)(F.ws + WS_X1);
    unsigned char* HID = F.ws + WS_HID; unsigned char* YBb = F.ws + WS_YB;

    if (IN(0)) { for (int rep = 0; rep <= DUP(0); ++rep) { if (rep) xcd_barrier(bar); REFRESH(); p0_prologue(F, F.G != 256); } } SEAM(0);
    for (int l = 0; l < NLAYER; ++l) {
        const int pb = 1 + 7 * l;
        if (IN(pb + 0)) {
            const bool side = (l == 0 && F.G == 256);
            constexpr int NCV = NCV_SET;
            if (side && F.bid < NCV) { REFRESH(); conv_weights(F, 0, 0, 0, 1, F.ctl + CW_Q); }
            else { const int gG = side ? F.G - NCV : F.G, gc = side ? F.bid - NCV : F.bid;
            { pg8::DenseOrder S{T / 256, 12, gG, gc, 2 * D, (const char*)Hb, (const char*)(F.ws + WS_WIN) + (size_t)l * NZ * D * 2};
              pg8::EpiConvIn E{Zb, NZ};
              pg8::gemm_phase<pg8::EpiConvIn, pg8::DenseOrder>(F.lds, 2 * D, S, E, F.wave); }
            { pg8::DenseOrder S{T / 256, 16, gG, gc, D, (const char*)(F.ws + WS_H8), (const char*)(F.ws + WS_WIN8) + (size_t)l * 4096 * D};
              pg8::EpiBf16 E{Zb, NZ, 3072};
              pg8::gemm_phase<pg8::EpiBf16, pg8::DenseOrder, true>(F.lds, D, S, E, F.wave); }
            if (side) { REFRESH(); conv_weights(F, 0, 0, 0, 1, F.ctl + CW_Q); } }
        } SEAM(pb + 0);
        if (IN(pb + 1)) {
            for (int rep = 0; rep <= DUP(2); ++rep) { if (rep) xcd_barrier(bar);
            REFRESH();
            for (int u = F.bid; u < 128; u += F.G) retention_unit(F, Zb, Yb, u >> 3, u & 7);
            const bool split = F.G >= 256;
            REFRESH();
            if (!split || F.bid >= 128) conv_items(F, l, Zb, Yb, split ? F.bid - 128 : F.bid, split ? F.G - 128 : F.G);
            if (F.G == 256 && F.bid >= 128) { REFRESH(); conv_weights(F, 0, 0, 0, 1, F.ctl + CW_Q2, 2, l == 0 ? P2_CHUNKS : 0x7fffffff); } }
        } SEAM(pb + 1);
        if (IN(pb + 2)) {
            pg8::DenseOrder S{T / 256, D / 256, F.G, F.bid, 2 * D, (const char*)Yb, (const char*)(F.ws + WS_WOUT) + (size_t)l * D * D * 2};
            pg8::EpiResid E{X1, D};
            for (int rep = 0; rep <= 0; ++rep) { if (rep) xcd_barrier(bar); pg8::gemm_phase<pg8::EpiResid, pg8::DenseOrder>(F.lds, 2 * D, S, E, F.wave); }
        } SEAM(pb + 2);
        if (IN(pb + 3)) { if (DUP(4)) { REFRESH(); router_phase(F, l, CW_CNT + 64); xcd_barrier(bar); } REFRESH(); router_phase(F, l, CW_CNT); } SEAM(pb + 3);
        if (IN(pb + 4)) {
            REFRESH(); moe_tables(F, l);
            pg8::MoeOrder<true> S{(int)F.MISC[MW_TSTART + NE], F.G, F.bid, D, (const char*)(F.ws + WS_H8), (const char*)(F.ws + WS_W13) + (size_t)l * NE * 2048 * D, (size_t)2048 * D,
                (const int*)(F.ws + WS_LIST), (const LAS int*)(F.MISC + MW_TILE), (const LAS int*)(F.MISC + MW_TSTART), (const LAS int*)(F.MISC + MW_CNT)};
            pg8::EpiSwiglu E{HID};
            for (int rep = 0; rep <= DUP(5); ++rep) { if (rep) xcd_barrier(bar); pg8::gemm_phase<pg8::EpiSwiglu, pg8::MoeOrder<true>, true>(F.lds, D, S, E, F.wave); }
        } SEAM(pb + 4);
        if (IN(pb + 5)) {
            REFRESH(); moe_tables(F, l);
            pg8::MoeOrder<false> S{(int)F.MISC[MW_TSTART + NE], F.G, F.bid, DE, (const char*)HID, (const char*)(F.ws + WS_W2) + (size_t)l * NE * D * DE, (size_t)D * DE,
                nullptr, (const LAS int*)(F.MISC + MW_TILE), (const LAS int*)(F.MISC + MW_TSTART), (const LAS int*)(F.MISC + MW_CNT)};
            pg8::EpiFp8 E{YBb, D};
            for (int rep = 0; rep <= DUP(6); ++rep) { if (rep) xcd_barrier(bar); pg8::gemm_phase<pg8::EpiFp8, pg8::MoeOrder<false>, true>(F.lds, DE, S, E, F.wave); }
        } SEAM(pb + 5);
        if (IN(pb + 6)) { REFRESH(); moe_tables(F, l); for (int rep = 0; rep <= (DUP(7) && l == NLAYER - 1 ? 1 : 0); ++rep) { if (rep) xcd_barrier(bar); combine_phase(F, l); } } SEAM(pb + 6);
    }
#undef IN
#undef SEAM
}

extern "C" void kernel_launch(void* const* d_in, const int* in_sizes, int n_in, void* d_out, int out_size, void* d_ws, size_t ws_size, hipStream_t stream) {
    static int grid = 0;
    if (grid == 0) {
        if (n_in != 14 || in_sizes[0] != T * D || out_size != T * D || ws_size < WS_END) { fprintf(stderr, "kernel_launch: unexpected shapes (n_in %d, in0 %d, out %d, ws %zu < %zu); nothing launched\n", n_in, n_in > 0 ? in_sizes[0] : -1, out_size, ws_size, (size_t)WS_END); grid = -1; return; }
        int dev = 0, cus = 0, per_cu = 0;
        if (hipGetDevice(&dev) != hipSuccess || hipDeviceGetAttribute(&cus, hipDeviceAttributeMultiprocessorCount, dev) != hipSuccess) { grid = -1; return; }
        if (hipFuncSetAttribute((const void*)mk_fwd, hipFuncAttributeMaxDynamicSharedMemorySize, LDS_BYTES) != hipSuccess) { fprintf(stderr, "kernel_launch: hipFuncSetAttribute failed\n"); grid = -1; return; }
        if (hipOccupancyMaxActiveBlocksPerMultiprocessor(&per_cu, (const void*)mk_fwd, NWAVES * 64, LDS_BYTES) != hipSuccess || per_cu < 1)
            fprintf(stderr, "kernel_launch: note: occupancy query reports %d workgroups per CU\n", per_cu);
        (void)hipGetLastError();
        grid = cus;
    }
    if (grid < 0) return;
    if (hipMemsetAsync((char*)d_ws + WS_CTL, 0, CTL_ZERO_BYTES, stream) != hipSuccess) { fprintf(stderr, "kernel_launch: memset failed\n"); return; }
    Args a{};
    for (int i = 0; i < 14; ++i) a.in[i] = (const float*)d_in[i];
    a.out = (float*)d_out; a.ws = (unsigned char*)d_ws;
#if MK_PER_PHASE
    for (int p = 0; p < NPHASE; ++p) { a.ph_lo = p; a.ph_hi = p + 1; hipLaunchKernelGGL(mk_fwd, dim3(grid), dim3(NWAVES * 64), LDS_BYTES, stream, a); }
#else
    a.ph_lo = 0; a.ph_hi = NPHASE;
    hipLaunchKernelGGL(mk_fwd, dim3(grid), dim3(NWAVES * 64), LDS_BYTES, stream, a);
#endif
    const hipError_t le = hipPeekAtLastError();
    if (le != hipSuccess) fprintf(stderr, "kernel_launch: launch failed: %s\n", hipGetErrorName(le));
}
```

```cpp
#include <hip/hip_runtime.h>
#include <cstdio>
#include <cstdint>

#ifndef DUP_MASK
#define DUP_MASK 0
#endif
#ifndef MK_PER_PHASE
#define MK_PER_PHASE 0
#ifndef NCV_SET
#define NCV_SET 40
#endif
#ifndef P2_CHUNKS
#define P2_CHUNKS 3
#endif
#endif

constexpr int T = 32768, D = 2048, NZ = 7168, SEQ = 2048, NHEAD = 8, HD = 128, CHUNK = 64;
constexpr int NE = 32, DE = 1024, NLAYER = 2;
constexpr int MAXROWS = 65536 + NE * 256;
constexpr int MAXTILES = MAXROWS / 256;
constexpr float EPS = 1e-6f;
constexpr int NPHASE = 1 + 7 * NLAYER;

constexpr size_t MiB = 1u << 20;
constexpr size_t WS_CTL = 0, CTL_ZERO_BYTES = 64 * 1024;
constexpr size_t WS_ROPE = 1 * MiB;
constexpr size_t WS_WR = 2 * MiB;
constexpr size_t WS_INFO = 3 * MiB;
constexpr size_t WS_LIST = 4 * MiB;
constexpr size_t WS_WIN = 8 * MiB;
constexpr size_t WS_WOUT = 64 * MiB;
constexpr size_t WS_W13 = 80 * MiB;
constexpr size_t WS_W2 = 336 * MiB;
constexpr size_t WS_H8 = 464 * MiB;
constexpr size_t WS_WIN8 = 528 * MiB;
constexpr size_t WS_H = 848 * MiB;
constexpr size_t WS_Z = 976 * MiB;
constexpr size_t WS_HID = WS_Z;
constexpr size_t WS_YB = WS_Z + 144 * MiB;
constexpr size_t WS_Y = 1424 * MiB;
constexpr size_t WS_X1 = 1552 * MiB;
constexpr size_t WS_END = 1808 * MiB;
static_assert((size_t)MAXROWS * 1024 * 2 <= 144 * MiB && (size_t)MAXROWS * 2048 * 2 <= 288 * MiB && 144 + 288 <= 448, "overlay");
constexpr int CW_BAR = 0, CW_CNT = 4096, CW_Q = 4352, CW_Q2 = 4416;

constexpr int MISC_OFF = 143360;
constexpr int LDS_BYTES = 147456;
constexpr int MW_BAR = 0, MW_TSTART = 16, MW_CNT = 64, MW_TILE = 128;
static_assert(MISC_OFF + (MW_TILE + 320) * 4 <= LDS_BYTES, "LDS map");

#define GAS __attribute__((address_space(1)))
#define LAS __attribute__((address_space(3)))
typedef unsigned short bf16;
typedef unsigned v4u __attribute__((ext_vector_type(4)));
typedef unsigned v2u __attribute__((ext_vector_type(2)));
typedef float f32x4 __attribute__((ext_vector_type(4)));
typedef float f32x2 __attribute__((ext_vector_type(2)));
typedef float f32x16 __attribute__((ext_vector_type(16)));
typedef short bf16x8 __attribute__((ext_vector_type(8)));
typedef int i32x4 __attribute__((ext_vector_type(4)));
#define LDS_WAIT() asm volatile("s_waitcnt lgkmcnt(0)" ::: "memory")
#define VM_WAIT() asm volatile("s_waitcnt vmcnt(0)" ::: "memory")
typedef __bf16 bf16v2 __attribute__((ext_vector_type(2)));
__device__ __forceinline__ unsigned pk2(float lo, float hi) { const bf16v2 v = __builtin_convertvector((f32x2){lo, hi}, bf16v2); return __builtin_bit_cast(unsigned, v); }
__device__ __forceinline__ unsigned f2bf(float f) { return pk2(f, 0.f) & 0xffffu; }
__device__ __forceinline__ float bflo(unsigned w) { return __builtin_bit_cast(float, w << 16); }
__device__ __forceinline__ float bfhi(unsigned w) { return __builtin_bit_cast(float, w & 0xffff0000u); }
__device__ __forceinline__ float bf2f(bf16 b) { return __builtin_bit_cast(float, ((unsigned)b) << 16); }
__device__ __forceinline__ float shx(float v, int o, int lane) { return __builtin_bit_cast(float, __builtin_amdgcn_ds_bpermute((lane ^ o) << 2, __builtin_bit_cast(int, v))); }
__device__ __forceinline__ float wave_sum(float v, int lane) {
#pragma unroll
    for (int o = 1; o < 64; o <<= 1) v += shx(v, o, lane);
    return v;
}

#define XB_TMO      128
#define XB_XCNT(j)  (256  + 64 * (j))
#define XB_XSUB(j)  (1280 + 64 * (j))
#define XB_XGEN(j)  (2304 + 64 * (j))
#define XB_TOP      3328
#define XB_TOPGEN   3392
#define XCD_BAR_WORDS 3456
#define XB_SPIN_CAP (1u << 20)
__device__ __forceinline__ unsigned xb_ld(unsigned* p)              { return __hip_atomic_load(p, __ATOMIC_RELAXED, __HIP_MEMORY_SCOPE_AGENT); }
__device__ __forceinline__ unsigned xb_add(unsigned* p, unsigned v) { return __hip_atomic_fetch_add(p, v, __ATOMIC_RELAXED, __HIP_MEMORY_SCOPE_AGENT); }
__device__ __forceinline__ unsigned xb_xcc_id() { return (unsigned)__builtin_amdgcn_s_getreg((3 << 11) | 20) & 0xFu; }
#define XB_SPIN(cond, bar) do { unsigned _sp = 0; while (cond) { __builtin_amdgcn_s_sleep(1); \
    if ((++_sp & 255u) == 0u) { if (xb_ld(&(bar)[XB_TMO])) break; if (_sp > XB_SPIN_CAP) { atomicAdd(&(bar)[XB_TMO], 1u); break; } } } } while (0)
struct XcdBarrier { unsigned* bar; unsigned x; volatile LAS unsigned* st; };
__device__ __forceinline__ XcdBarrier xcd_barrier_post(unsigned* bar, volatile LAS unsigned* st) {
    XcdBarrier b; b.bar = bar; b.x = xb_xcc_id(); b.st = st;
    if (threadIdx.x == 0) (void)xb_add(&bar[XB_XCNT(b.x)], 1u);
    return b;
}
__device__ __forceinline__ void xcd_barrier_complete(unsigned* bar, unsigned x, unsigned& nloc, unsigned& nx) {
    const unsigned G = gridDim.x * gridDim.y * gridDim.z;
    unsigned sum, cnt, mine, sp = 0u;
    for (;;) {
        sum = 0u; cnt = 0u; mine = 0u;
#pragma unroll
        for (unsigned j = 0; j < 16; ++j) { const unsigned c = xb_ld(&bar[XB_XCNT(j)]); sum += c; cnt += (c > 0u) ? 1u : 0u; mine = (j == x) ? c : mine; }
        if (sum == G) break;
        __builtin_amdgcn_s_sleep(1);
        if ((++sp & 255u) == 0u) { if (xb_ld(&bar[XB_TMO])) break; if (sp > XB_SPIN_CAP) { atomicAdd(&bar[XB_TMO], 1u); break; } }
    }
    nloc = mine > 0u ? mine : 1u; nx = cnt > 0u ? cnt : 1u;
}
__device__ __forceinline__ void xcd_barrier(const XcdBarrier& b) {
    asm volatile("s_waitcnt vmcnt(0)" ::: "memory");
    __syncthreads();
    if (threadIdx.x == 0) {
        unsigned* bar = b.bar; unsigned bx = b.x;
        asm volatile("" : "+s"(bar), "+s"(bx));
        __builtin_amdgcn_s_waitcnt(0);
        unsigned nloc = b.st[0], nx = b.st[1];
        if (nloc == 0u) { xcd_barrier_complete(bar, bx, nloc, nx); b.st[0] = nloc; b.st[1] = nx; }
        const unsigned old = xb_add(&bar[XB_XSUB(bx)], 1u);
        const unsigned gen = old / nloc;
        if (old + 1u == (gen + 1u) * nloc) {
            __builtin_amdgcn_fence(__ATOMIC_RELEASE, "agent");
            asm volatile("s_waitcnt vmcnt(0)" ::: "memory");
            const unsigned og = xb_add(&bar[XB_TOP], 1u);
            const unsigned tg = og / nx;
            if (og + 1u == (tg + 1u) * nx) xb_add(&bar[XB_TOPGEN], 1u);
            else XB_SPIN(xb_ld(&bar[XB_TOPGEN]) == tg, bar);
            __builtin_amdgcn_fence(__ATOMIC_ACQUIRE, "agent");
            xb_add(&bar[XB_XGEN(bx)], 1u);
            asm volatile("s_waitcnt vmcnt(0)" ::: "memory");
        } else {
            XB_SPIN(xb_ld(&bar[XB_XGEN(bx)]) == gen, bar);
            __builtin_amdgcn_fence(__ATOMIC_ACQUIRE, "agent");
            asm volatile("s_waitcnt vmcnt(0)" ::: "memory");
        }
    }
    __syncthreads();
}

namespace pg8 {
#define PG8_LAS __attribute__((address_space(3)))
typedef unsigned short bf16_t;
typedef unsigned u32x4 __attribute__((ext_vector_type(4)));
constexpr int BM = 256, BK = 64, HALF = 128, HTB = HALF * BK * 2, STAGE_BYTES = 8 * HTB, NXCD = 8, WGM = 8;
__host__ __device__ __forceinline__ int lds_byte(int r, int c) { const int st = (r >> 4) * 2 + (c >> 5), rr = r & 15, cc = c & 31, ob = rr * 64 + cc * 2; return st * 1024 + (ob ^ (((ob >> 9) & 1) << 5)); }
__host__ __device__ __forceinline__ void stage_rc(int b, int& R, int& C) { const int st = b / 1024, sb = b % 1024, swz = sb ^ (((sb >> 9) & 1) << 5); R = (st >> 1) * 16 + swz / 64; C = (st & 1) * 32 + (swz % 64) / 2; }
__host__ __device__ __forceinline__ int perm32(int rho) { const int n = rho >> 4, i = rho & 15; return 8 * (i >> 2) + 4 * n + (i & 3); }

struct Unit { int pm, pn, e; };
typedef int i32x8 __attribute__((ext_vector_type(8)));
typedef int i32x4v __attribute__((ext_vector_type(4)));
struct Frag { i32x8 v; };
__device__ __forceinline__ Frag ldfrag2(const PG8_LAS unsigned char* p) { Frag f; f.v = __builtin_shufflevector(*(const PG8_LAS i32x4v*)p, *(const PG8_LAS i32x4v*)(p + 1024), 0, 1, 2, 3, 4, 5, 6, 7); return f; }
__device__ __forceinline__ bf16x8 fhalf(const Frag& f, int k) { const i32x4v h = k ? __builtin_shufflevector(f.v, f.v, 4, 5, 6, 7) : __builtin_shufflevector(f.v, f.v, 0, 1, 2, 3); return __builtin_bit_cast(bf16x8, h); }
__device__ __forceinline__ unsigned cvt_pk_bf16(float lo, float hi) { unsigned r; asm volatile("v_cvt_pk_bf16_f32 %0, %1, %2" : "=v"(r) : "v"(lo), "v"(hi)); return r; }

__device__ __forceinline__ bool order_next(int nM, int nN, int G, int c, int i, int& pm, int& pn) {
    const int nwg = nM * nN; const long L = (long)i * G + c; if (L >= nwg) return false;
    int wgid = (int)L; { const int q = nwg / NXCD, r = nwg % NXCD, xcd = wgid % NXCD, off = wgid / NXCD; wgid = (xcd < r ? xcd * (q + 1) : r * (q + 1) + (xcd - r) * q) + off; }
    const int nig = WGM * nN, gid = wgid / nig, fm = gid * WGM, gsz = (nM - fm) < WGM ? (nM - fm) : WGM;
    pm = fm + ((wgid % nig) % gsz); pn = (wgid % nig) / gsz; return true;
}
struct DenseOrder {
    int nM, nN, G, c, KB; const char* A; const char* Bt;
    __device__ __forceinline__ bool next(int i, Unit& u) const { u.e = 0; return order_next(nM, nN, G, c, i, u.pm, u.pn); }
    __device__ __forceinline__ const char* a_base(const Unit& u) const { return A + (size_t)u.pm * (size_t)BM * KB; }
    __device__ __forceinline__ const char* b_base(const Unit& u) const { return Bt + (size_t)u.pn * (size_t)BM * KB; }
    __device__ __forceinline__ void a_offs(const Unit&, const int (&R)[2], const int (&Cb)[2], unsigned (&vo)[2][2]) const {
#pragma unroll
        for (int h = 0; h < 2; ++h)
#pragma unroll
            for (int i = 0; i < 2; ++i) vo[h][i] = (unsigned)((h * HALF + R[i]) * KB + Cb[i]);
    }
    __device__ __forceinline__ void a_idx(const Unit&, const int (&R)[2], int (&tok)[2][2]) const {
#pragma unroll
        for (int h = 0; h < 2; ++h)
#pragma unroll
            for (int i = 0; i < 2; ++i) tok[h][i] = h * HALF + R[i]; }
    __device__ __forceinline__ void a_vo(const int (&tok)[2][2], const int (&Cb)[2], unsigned (&vo)[2][2]) const {
#pragma unroll
        for (int h = 0; h < 2; ++h)
#pragma unroll
            for (int i = 0; i < 2; ++i) vo[h][i] = (unsigned)tok[h][i] * (unsigned)KB + (unsigned)Cb[i]; }
};
template <bool GATHER> struct MoeOrder {
    int nT, G, c, KB; const char* A; const char* Bt; size_t bexp;
    const int* list; const LAS int* tile_e; const LAS int* tstart; const LAS int* cnt;
    __device__ __forceinline__ bool next(int i, Unit& u) const { if (!order_next(nT, 8, G, c, i, u.pm, u.pn)) return false; u.e = tile_e[u.pm]; return true; }
    __device__ __forceinline__ const char* a_base(const Unit& u) const { return GATHER ? A : A + (size_t)u.pm * (size_t)BM * KB; }
    __device__ __forceinline__ const char* b_base(const Unit& u) const { return Bt + (size_t)u.e * bexp + (size_t)u.pn * (size_t)BM * KB; }
    __device__ __forceinline__ void a_offs(const Unit& u, const int (&R)[2], const int (&Cb)[2], unsigned (&vo)[2][2]) const {
        if (GATHER) {
            const int base = (u.pm - tstart[u.e]) * BM, n = cnt[u.e]; const int* le = list + (size_t)u.e * T;
            int tok[2][2];
#pragma unroll
            for (int h = 0; h < 2; ++h)
#pragma unroll
                for (int i = 0; i < 2; ++i) { const int s = base + h * HALF + R[i]; tok[h][i] = le[s < n ? s : 0]; }
#pragma unroll
            for (int h = 0; h < 2; ++h)
#pragma unroll
                for (int i = 0; i < 2; ++i) vo[h][i] = (unsigned)tok[h][i] * (unsigned)KB + (unsigned)Cb[i];
        } else {
#pragma unroll
            for (int h = 0; h < 2; ++h)
#pragma unroll
                for (int i = 0; i < 2; ++i) vo[h][i] = (unsigned)((h * HALF + R[i]) * KB + Cb[i]);
        }
    }
    __device__ __forceinline__ void a_idx(const Unit& u, const int (&R)[2], int (&tok)[2][2]) const {
        if (GATHER) { const int base = (u.pm - tstart[u.e]) * BM, n = cnt[u.e]; const int* le = list + (size_t)u.e * T;
#pragma unroll
            for (int h = 0; h < 2; ++h)
#pragma unroll
                for (int i = 0; i < 2; ++i) { const int s = base + h * HALF + R[i]; tok[h][i] = le[s < n ? s : 0]; } }
        else {
#pragma unroll
            for (int h = 0; h < 2; ++h)
#pragma unroll
                for (int i = 0; i < 2; ++i) tok[h][i] = h * HALF + R[i]; } }
    __device__ __forceinline__ void a_vo(const int (&tok)[2][2], const int (&Cb)[2], unsigned (&vo)[2][2]) const {
#pragma unroll
        for (int h = 0; h < 2; ++h)
#pragma unroll
            for (int i = 0; i < 2; ++i) vo[h][i] = (unsigned)tok[h][i] * (unsigned)KB + (unsigned)Cb[i]; }
};

struct EpiBf16 {
    static constexpr bool PERM = true;
    bf16_t* O; int ldc; int coff;
    __device__ __forceinline__ void operator()(const f32x4 (&acc)[2][2][4][2], const Unit& u, int wr, int wc, int fr, int fq) const {
        const int row0 = u.pm * BM + wr * 64 + fr, col0 = coff + u.pn * BM + wc * 32 + 8 * fq;
#pragma unroll
        for (int ai = 0; ai < 2; ++ai)
#pragma unroll
            for (int m = 0; m < 4; ++m) { bf16_t* rowp = O + (size_t)(row0 + ai * HALF + m * 16) * ldc + col0;
#pragma unroll
                for (int bj = 0; bj < 2; ++bj) { const f32x4 v0 = acc[ai][bj][m][0], v1 = acc[ai][bj][m][1];
                    u32x4 w; w.x = cvt_pk_bf16(v0[0], v0[1]); w.y = cvt_pk_bf16(v0[2], v0[3]); w.z = cvt_pk_bf16(v1[0], v1[1]); w.w = cvt_pk_bf16(v1[2], v1[3]);
                    *(u32x4*)(rowp + bj * HALF) = w; } }
    }
};
struct EpiFp8 {
    static constexpr bool PERM = true;
    unsigned char* O; int ldc;
    __device__ __forceinline__ void operator()(const f32x4 (&acc)[2][2][4][2], const Unit& u, int wr, int wc, int fr, int fq) const {
        const int row0 = u.pm * BM + wr * 64 + fr, col0 = u.pn * BM + wc * 32 + 8 * fq;
        typedef int i32x2 __attribute__((ext_vector_type(2)));
#pragma unroll
        for (int ai = 0; ai < 2; ++ai)
#pragma unroll
            for (int m = 0; m < 4; ++m) { unsigned char* rowp = O + (size_t)(row0 + ai * HALF + m * 16) * ldc + col0;
#pragma unroll
                for (int bj = 0; bj < 2; ++bj) { const f32x4 v0 = acc[ai][bj][m][0], v1 = acc[ai][bj][m][1];
                    int w0 = 0, w1 = 0; w0 = __builtin_amdgcn_cvt_pk_fp8_f32(v0[0], v0[1], w0, false); w0 = __builtin_amdgcn_cvt_pk_fp8_f32(v0[2], v0[3], w0, true);
                    w1 = __builtin_amdgcn_cvt_pk_fp8_f32(v1[0], v1[1], w1, false); w1 = __builtin_amdgcn_cvt_pk_fp8_f32(v1[2], v1[3], w1, true);
                    *(i32x2*)(rowp + bj * HALF) = (i32x2){w0, w1}; } }
    }
};
struct EpiConvIn {
    static constexpr bool PERM = true;
    bf16_t* O; int ldc;
    __device__ __forceinline__ void operator()(const f32x4 (&acc)[2][2][4][2], const Unit& u, int wr, int wc, int fr, int fq) const {
        const int row0 = u.pm * BM + wr * 64 + fr;
        if (u.pn < 4) { const int col0 = u.pn * BM + wc * 32 + 8 * fq;
#pragma unroll
            for (int ai = 0; ai < 2; ++ai)
#pragma unroll
                for (int m = 0; m < 4; ++m) { bf16_t* rowp = O + (size_t)(row0 + ai * HALF + m * 16) * ldc + col0;
#pragma unroll
                    for (int bj = 0; bj < 2; ++bj) { const f32x4 v0 = acc[ai][bj][m][0], v1 = acc[ai][bj][m][1];
                        u32x4 w; w.x = cvt_pk_bf16(v0[0], v0[1]); w.y = cvt_pk_bf16(v0[2], v0[3]); w.z = cvt_pk_bf16(v1[0], v1[1]); w.w = cvt_pk_bf16(v1[2], v1[3]);
                        *(u32x4*)(rowp + bj * HALF) = w; } } }
        else { const int col0 = 1024 + (u.pn - 4) * HALF + wc * 32 + 8 * fq;
#pragma unroll
            for (int ai = 0; ai < 2; ++ai)
#pragma unroll
                for (int m = 0; m < 4; ++m) { const f32x4 c0 = acc[ai][0][m][0], c1 = acc[ai][0][m][1], v0 = acc[ai][1][m][0], v1 = acc[ai][1][m][1];
                    u32x4 w; w.x = cvt_pk_bf16(c0[0] * v0[0], c0[1] * v0[1]); w.y = cvt_pk_bf16(c0[2] * v0[2], c0[3] * v0[3]); w.z = cvt_pk_bf16(c1[0] * v1[0], c1[1] * v1[1]); w.w = cvt_pk_bf16(c1[2] * v1[2], c1[3] * v1[3]);
                    *(u32x4*)(O + (size_t)(row0 + ai * HALF + m * 16) * ldc + col0) = w; } }
    }
};
struct EpiResid {
    static constexpr bool PERM = true;
    bf16_t* X; int ldc;
    __device__ __forceinline__ void operator()(const f32x4 (&acc)[2][2][4][2], const Unit& u, int wr, int wc, int fr, int fq) const {
        const int row0 = u.pm * BM + wr * 64 + fr, col0 = u.pn * BM + wc * 32 + 8 * fq;
        u32x4 rs[2][4][2];
#pragma unroll
        for (int ai = 0; ai < 2; ++ai)
#pragma unroll
            for (int m = 0; m < 4; ++m) { const bf16_t* rowp = X + (size_t)(row0 + ai * HALF + m * 16) * ldc + col0;
#pragma unroll
                for (int bj = 0; bj < 2; ++bj) rs[ai][m][bj] = *(const u32x4*)(rowp + bj * HALF); }
#pragma unroll
        for (int ai = 0; ai < 2; ++ai)
#pragma unroll
            for (int m = 0; m < 4; ++m) { bf16_t* rowp = X + (size_t)(row0 + ai * HALF + m * 16) * ldc + col0;
#pragma unroll
                for (int bj = 0; bj < 2; ++bj) { const u32x4 bs = rs[ai][m][bj]; const f32x4 v0 = acc[ai][bj][m][0], v1 = acc[ai][bj][m][1];
                    u32x4 w; w.x = cvt_pk_bf16(v0[0] + __builtin_bit_cast(float, bs.x << 16), v0[1] + __builtin_bit_cast(float, bs.x & 0xffff0000u)); w.y = cvt_pk_bf16(v0[2] + __builtin_bit_cast(float, bs.y << 16), v0[3] + __builtin_bit_cast(float, bs.y & 0xffff0000u));
                    w.z = cvt_pk_bf16(v1[0] + __builtin_bit_cast(float, bs.z << 16), v1[1] + __builtin_bit_cast(float, bs.z & 0xffff0000u)); w.w = cvt_pk_bf16(v1[2] + __builtin_bit_cast(float, bs.w << 16), v1[3] + __builtin_bit_cast(float, bs.w & 0xffff0000u));
                    *(u32x4*)(rowp + bj * HALF) = w; } }
    }
};
struct EpiSwiglu {
    static constexpr bool PERM = true;
    unsigned char* O;
    __device__ __forceinline__ void operator()(const f32x4 (&acc)[2][2][4][2], const Unit& u, int wr, int wc, int fr, int fq) const {
        const int row0 = u.pm * BM + wr * 64 + fr, col0 = u.pn * HALF + wc * 32 + 8 * fq;
#pragma unroll
        for (int ai = 0; ai < 2; ++ai)
#pragma unroll
            for (int m = 0; m < 4; ++m) { unsigned char* rowp = O + (size_t)(row0 + ai * HALF + m * 16) * 1024 + col0; float r[8];
#pragma unroll
                for (int n = 0; n < 2; ++n)
#pragma unroll
                    for (int j = 0; j < 4; ++j) { const float g = acc[ai][0][m][n][j], up = acc[ai][1][m][n][j]; r[4 * n + j] = g * up * __builtin_amdgcn_rcpf(1.0f + __expf(-g)); }
                int w0 = 0, w1 = 0; w0 = __builtin_amdgcn_cvt_pk_fp8_f32(r[0], r[1], w0, false); w0 = __builtin_amdgcn_cvt_pk_fp8_f32(r[2], r[3], w0, true);
                w1 = __builtin_amdgcn_cvt_pk_fp8_f32(r[4], r[5], w1, false); w1 = __builtin_amdgcn_cvt_pk_fp8_f32(r[6], r[7], w1, true);
                typedef int i32x2 __attribute__((ext_vector_type(2))); *(i32x2*)rowp = (i32x2){w0, w1}; }
    }
};

template <class Epi, class Sched, bool FP8 = false>
__device__ __forceinline__ void gemm_phase(PG8_LAS unsigned char* lds, const int KB, const Sched& S, const Epi& E, const int wave_id) {
    unsigned m_ = ~0u; asm volatile("" : "+s"(m_)); const int lane_ = (int)__builtin_amdgcn_mbcnt_hi(m_, __builtin_amdgcn_mbcnt_lo(m_, 0u));
    int wid_ = wave_id; asm volatile("" : "+s"(wid_));
    const int wid = wid_, lane = lane_, tid = wid * 64 + lane, wr = wid >> 2, wc = wid & 3, fr = lane & 15, fq = lane >> 4;
    const int nt = KB / (BK * 2);
    unsigned voffB[2]; int Rr[2], Cb[2];
#pragma unroll
    for (int i = 0; i < 2; ++i) { int R, C; stage_rc(tid * 16 + i * 8192, R, C); const int Rb = Epi::PERM ? ((R & ~31) + perm32(R & 31)) : R;
        Rr[i] = R; Cb[i] = C * 2; voffB[i] = (unsigned)(Rb * KB + C * 2); }
    const size_t kstep = (size_t)(BK * 2);
    const size_t hstep = (size_t)HALF * KB;
    const unsigned ldsw = (unsigned)wid * 1024u;
    const int aoff = lds_byte(wr * 64 + fr, fq * 8), boff = lds_byte(wc * 32 + fr, fq * 8);
#define PG8_SA(b, h) (((b) * 2 + (h)) * HTB)
#define PG8_SB(b, h) ((4 + (b) * 2 + (h)) * HTB)
#define PG8_STAGE(bufoff, gbase, voff) do { _Pragma("unroll") for (int _i = 0; _i < 2; ++_i) \
        __builtin_amdgcn_global_load_lds((const unsigned*)((const char*)(gbase) + (voff)[_i]), (PG8_LAS unsigned*)(lds + (bufoff) + ldsw + _i * 8192), 16, 0, 0); } while (0)
#define PG8_LDA(dst, b, h) do { _Pragma("unroll") for (int m = 0; m < 4; ++m) dst[m] = ldfrag2(lds + PG8_SA(b, h) + aoff + m * 2048); } while (0)
#define PG8_LDB(dst, b, h) do { _Pragma("unroll") for (int n = 0; n < 2; ++n) dst[n] = ldfrag2(lds + PG8_SB(b, h) + boff + n * 2048); } while (0)
#define PG8_MMA(ai, bj, At, Bt) do { __builtin_amdgcn_s_setprio(1); _Pragma("unroll") for (int m = 0; m < 4; ++m) _Pragma("unroll") for (int n = 0; n < 2; ++n) { \
        if constexpr (FP8) { asm volatile("v_mfma_scale_f32_16x16x128_f8f6f4 %0, %1, %2, %0, %3, %4 op_sel_hi:[0,0,0]" : "+v"(acc[ai][bj][m][n]) : "v"(Bt[n].v), "v"(At[m].v), "v"(sc_w), "v"(sc_1)); } \
        else { _Pragma("unroll") for (int k = 0; k < 2; ++k) acc[ai][bj][m][n] = __builtin_amdgcn_mfma_f32_16x16x32_bf16(fhalf(Bt[n], k), fhalf(At[m], k), acc[ai][bj][m][n], 0, 0, 0); } } __builtin_amdgcn_s_setprio(0); } while (0)
#define PG8_WAIT_V(n) asm volatile("s_waitcnt vmcnt(" #n ")" ::: "memory")
#define PG8_WAIT_L(n) asm volatile("s_waitcnt lgkmcnt(" #n ")" ::: "memory")
#define PG8_BAR __builtin_amdgcn_s_barrier()
#define PG8_SCHED __builtin_amdgcn_sched_barrier(0)
    Unit cur, nxt; int ui = 0;
    if (!S.next(0, cur)) return;
    f32x4 acc[2][2][4][2];
#pragma unroll
    for (int a = 0; a < 2; ++a)
#pragma unroll
        for (int b = 0; b < 2; ++b)
#pragma unroll
            for (int m = 0; m < 4; ++m)
#pragma unroll
                for (int n = 0; n < 2; ++n) acc[a][b][m][n] = (f32x4){0.f, 0.f, 0.f, 0.f};
    Frag At[4], B0[2], B1[2];
    int sc_w = 0x79797979, sc_1 = 0x7f7f7f7f;
    if constexpr (FP8) asm volatile("" : "+v"(sc_w), "+v"(sc_1));
    unsigned voA[2][2], voN[2][2];
    S.a_offs(cur, Rr, Cb, voA);
    const char* cA = S.a_base(cur); const char* cB = S.b_base(cur);
    PG8_STAGE(PG8_SB(0, 0), cB, voffB); PG8_STAGE(PG8_SB(0, 1), cB + hstep, voffB); PG8_STAGE(PG8_SA(0, 0), cA, voA[0]); PG8_STAGE(PG8_SA(0, 1), cA, voA[1]);
    if (wr == 1) PG8_BAR;
    PG8_WAIT_V(2); PG8_BAR;
    PG8_STAGE(PG8_SB(1, 0), cB + kstep, voffB); PG8_STAGE(PG8_SA(1, 0), cA + kstep, voA[0]); PG8_STAGE(PG8_SB(1, 1), cB + hstep + kstep, voffB);
    PG8_WAIT_V(6); PG8_BAR;
    bool has_next = S.next(ui + 1, nxt);
    const char* nA = cA; const char* nB = cB;
    if (has_next) { S.a_offs(nxt, Rr, Cb, voN); nA = S.a_base(nxt); nB = S.b_base(nxt); }
    else {
#pragma unroll
        for (int h = 0; h < 2; ++h)
#pragma unroll
            for (int i = 0; i < 2; ++i) voN[h][i] = voA[h][i];
    }
    asm volatile("" : "+v"(voN[0][0]), "+v"(voN[0][1]), "+v"(voN[1][0]), "+v"(voN[1][1]));
    for (;;) {
#pragma nounroll
        for (int t = 0; t < nt; t += 2) {
            const bool last = (t == nt - 2);
            const char* a1 = cA + (size_t)(t + 1) * kstep;
            const char* a2 = last ? nA : cA + (size_t)(t + 2) * kstep; const char* b2 = last ? nB : cB + (size_t)(t + 2) * kstep;
            const char* a3 = a2 + kstep; const char* b3 = b2 + kstep;
            unsigned vo2[2][2];
#pragma unroll
            for (int h = 0; h < 2; ++h)
#pragma unroll
                for (int i = 0; i < 2; ++i) vo2[h][i] = last ? voN[h][i] : voA[h][i];
            PG8_LDB(B0, 0, 0); PG8_LDB(B1, 0, 1); PG8_SCHED; PG8_LDA(At, 0, 0); PG8_STAGE(PG8_SA(1, 1), a1, voA[1]);
            PG8_WAIT_V(8); PG8_WAIT_L(0); PG8_BAR; PG8_MMA(0, 0, At, B0); PG8_MMA(0, 1, At, B1); PG8_BAR; PG8_SCHED;
            PG8_LDA(At, 0, 1); PG8_STAGE(PG8_SB(0, 0), b2, voffB); PG8_STAGE(PG8_SB(0, 1), b2 + hstep, voffB); PG8_STAGE(PG8_SA(0, 0), a2, vo2[0]);
            PG8_WAIT_V(8); PG8_WAIT_L(0); PG8_BAR; PG8_MMA(1, 0, At, B0); PG8_MMA(1, 1, At, B1); PG8_BAR; PG8_SCHED;
            PG8_LDB(B0, 1, 0); PG8_LDB(B1, 1, 1); PG8_SCHED; PG8_LDA(At, 1, 0); PG8_STAGE(PG8_SA(0, 1), a2, vo2[1]);
            PG8_WAIT_V(8); PG8_WAIT_L(0); PG8_BAR; PG8_MMA(0, 0, At, B0); PG8_MMA(0, 1, At, B1); PG8_BAR; PG8_SCHED;
            PG8_LDA(At, 1, 1); PG8_STAGE(PG8_SB(1, 0), b3, voffB); PG8_STAGE(PG8_SB(1, 1), b3 + hstep, voffB); PG8_STAGE(PG8_SA(1, 0), a3, vo2[0]);
            PG8_WAIT_V(8); PG8_WAIT_L(0); PG8_BAR; PG8_MMA(1, 0, At, B0); PG8_MMA(1, 1, At, B1); PG8_BAR; PG8_SCHED;
        }
        if (wr == 0) PG8_BAR;
        if constexpr (FP8) asm volatile("s_nop 15\n\ts_nop 15" ::: "memory");
        Unit nn; nn.pm = 0; nn.pn = 0; nn.e = 0; bool has_nn = false; int tokn[2][2] = {{0, 0}, {0, 0}};
        if (has_next) { has_nn = S.next(ui + 2, nn); if (has_nn) S.a_idx(nn, Rr, tokn); }
        asm volatile("" ::: "memory");
        E(acc, cur, wr, wc, fr, fq);
        if (!has_next) break;
#pragma unroll
        for (int a = 0; a < 2; ++a)
#pragma unroll
            for (int b = 0; b < 2; ++b)
#pragma unroll
                for (int m = 0; m < 4; ++m)
#pragma unroll
                    for (int n = 0; n < 2; ++n) acc[a][b][m][n] = (f32x4){0.f, 0.f, 0.f, 0.f};
        if constexpr (FP8) asm volatile("s_nop 7" ::: "memory");
        cur = nxt; cA = nA; cB = nB; ++ui;
#pragma unroll
        for (int h = 0; h < 2; ++h)
#pragma unroll
            for (int i = 0; i < 2; ++i) voA[h][i] = voN[h][i];
        has_next = has_nn;
        if (has_nn) { nxt = nn; asm volatile("" : "+v"(tokn[0][0]), "+v"(tokn[0][1]), "+v"(tokn[1][0]), "+v"(tokn[1][1])); S.a_vo(tokn, Cb, voN); nA = S.a_base(nn); nB = S.b_base(nn); }
        else { nA = cA; nB = cB; }
        asm volatile("" : "+v"(voN[0][0]), "+v"(voN[0][1]), "+v"(voN[1][0]), "+v"(voN[1][1]));
        if (wr == 1) PG8_BAR;
    }
    PG8_WAIT_V(0);
    PG8_BAR;
#undef PG8_SA
#undef PG8_SB
#undef PG8_STAGE
#undef PG8_LDA
#undef PG8_LDB
#undef PG8_MMA
#undef PG8_WAIT_V
#undef PG8_WAIT_L
#undef PG8_BAR
#undef PG8_SCHED
}
}

struct Frame {
    LAS unsigned char* lds;
    volatile LAS unsigned* MISC;
    unsigned* ctl;
    int tid, lane, wave, G, bid;
    const float *x, *g_mix, *w_in, *conv_w, *w_out, *g_ffn, *w_group, *b_group, *w_router, *b_router, *w_gate, *w_up, *w_down, *g_final;
    float* out;
    unsigned char* ws;
};
constexpr int NWAVES = 8;

__device__ __forceinline__ void tr_item(const float* W, int ldw, int k0, int n0, bf16* WT, int ldd, int drow0, float scale, LAS float* scr, int lane) {
    float v[32];
#pragma unroll
    for (int i = 0; i < 32; ++i) v[i] = W[(size_t)(k0 + 2 * i + (lane >> 5)) * ldw + n0 + (lane & 31)];
#pragma unroll
    for (int i = 0; i < 32; ++i) scr[(2 * i + (lane >> 5)) * 33 + (lane & 31)] = v[i] * scale;
    LDS_WAIT(); asm volatile("" ::: "memory");
    const int c = lane & 7;
#pragma unroll
    for (int j = 0; j < 4; ++j) { const int n = (lane >> 3) + 8 * j; const LAS float* s = scr + (8 * c) * 33 + n;
        v4u o; o.x = pk2(s[0 * 33], s[1 * 33]); o.y = pk2(s[2 * 33], s[3 * 33]); o.z = pk2(s[4 * 33], s[5 * 33]); o.w = pk2(s[6 * 33], s[7 * 33]);
        *(v4u*)(WT + (size_t)(drow0 + n) * ldd + k0 + 8 * c) = o; }
    LDS_WAIT(); asm volatile("" ::: "memory");
}
__device__ __forceinline__ void tr_item8(const float* W, int ldw, int k0, int n0, unsigned char* WT, int ldd, int drow0, float scale, LAS float* scr, int lane) {
    float v[64];
#pragma unroll
    for (int i = 0; i < 64; ++i) v[i] = W[(size_t)(k0 + 2 * i + (lane >> 5)) * ldw + n0 + (lane & 31)];
#pragma unroll
    for (int i = 0; i < 64; ++i) scr[(2 * i + (lane >> 5)) * 33 + (lane & 31)] = v[i] * scale;
    LDS_WAIT(); asm volatile("" ::: "memory");
    const int c = lane & 7;
#pragma unroll
    for (int j = 0; j < 4; ++j) { const int n = (lane >> 3) + 8 * j; const LAS float* sp = scr + (16 * c) * 33 + n; int w[4];
#pragma unroll
        for (int q = 0; q < 4; ++q) { int t = 0; t = __builtin_amdgcn_cvt_pk_fp8_f32(sp[(4 * q + 0) * 33], sp[(4 * q + 1) * 33], t, false); t = __builtin_amdgcn_cvt_pk_fp8_f32(sp[(4 * q + 2) * 33], sp[(4 * q + 3) * 33], t, true); w[q] = t; }
        *(v4u*)(WT + (size_t)(drow0 + n) * ldd + k0 + 16 * c) = (v4u){(unsigned)w[0], (unsigned)w[1], (unsigned)w[2], (unsigned)w[3]}; }
    LDS_WAIT(); asm volatile("" ::: "memory");
}
__device__ __forceinline__ unsigned pk4_fp8(float a, float b, float c, float d) { int w = 0; w = __builtin_amdgcn_cvt_pk_fp8_f32(a, b, w, false); w = __builtin_amdgcn_cvt_pk_fp8_f32(c, d, w, true); return (unsigned)w; }
__device__ __forceinline__ void norm_row_bf16(const float* xrow, const float* g, bf16* orow, unsigned char* orow8, bf16* xcopy, int lane) {
    const f32x4* xr = (const f32x4*)xrow + lane; f32x4 v[8]; float s = 0.f; v2u* xc = (v2u*)xcopy + lane;
#pragma unroll
    for (int j = 0; j < 8; ++j) { v[j] = xr[64 * j]; s += (v[j].x * v[j].x + v[j].y * v[j].y) + (v[j].z * v[j].z + v[j].w * v[j].w); xc[64 * j] = (v2u){pk2(v[j].x, v[j].y), pk2(v[j].z, v[j].w)}; }
    const float rstd = 1.0f / sqrtf(wave_sum(s, lane) * (1.0f / D) + EPS);
    const f32x4* gr = (const f32x4*)g + lane; v2u* o8 = (v2u*)orow + lane; unsigned* of8 = (unsigned*)orow8 + lane;
#pragma unroll
    for (int j = 0; j < 8; ++j) { const f32x4 gv = gr[64 * j]; const f32x4 hv = v[j] * rstd * gv; v2u o; o.x = pk2(hv.x, hv.y); o.y = pk2(hv.z, hv.w); o8[64 * j] = o; of8[64 * j] = pk4_fp8(hv.x, hv.y, hv.z, hv.w); }
}
__device__ __forceinline__ void sincos_d(double a, float& c, float& s) {
    const double twopi = 6.283185307179586476925286766559, inv = 0.15915494309189533576888376337251;
    const double r = a - twopi * __builtin_rint(a * inv), r2 = r * r;
    double ss = 0.0, cc = 0.0;
#pragma unroll
    for (int k = 12; k >= 1; --k) { ss = (ss + 1.0) * (-r2 / (double)((2 * k) * (2 * k + 1))); cc = (cc + 1.0) * (-r2 / (double)((2 * k - 1) * (2 * k))); }
    s = (float)(r * (1.0 + ss)); c = (float)(1.0 + cc);
}
constexpr int I_IN = NLAYER * 32 * 96, I_IN8 = NLAYER * 16 * 128, I_OUT = NLAYER * 32 * 64, I_G = NLAYER * NE * 16 * 32, I_D = NLAYER * NE * 8 * 64;
constexpr int NITEMS = I_IN + I_IN8 + I_OUT + 2 * I_G + I_D;
__device__ __forceinline__ int cw_vit(int qsel, int v) {
    constexpr int hIN = I_IN / 2, hIN8 = I_IN8 / 2, hG = I_G / 2, hD = I_D / 2, oG = I_IN + I_IN8 + I_OUT, oU = oG + I_G, oD = oU + I_G;
    if (qsel == 2) return v < hG ? oG + hG + v : (v < 2 * hG ? oU + hG + (v - hG) : oD + hD + (v - 2 * hG));
    if (v < hIN) return hIN + v; v -= hIN;
    if (v < hIN8) return I_IN + hIN8 + v; v -= hIN8;
    if (v < I_OUT) return I_IN + I_IN8 + v; v -= I_OUT;
    if (v < hG) return oG + v; v -= hG;
    if (v < hG) return oU + v; v -= hG;
    return oD + v;
}
__device__ __forceinline__ void conv_weights(Frame& F, int it_lo, int it_hi, int cb, int ncb, unsigned* q = nullptr, const int qsel = 1, const int maxc = 0x7fffffff) {
    LAS float* scr = (LAS float*)(F.lds + F.wave * 17408);
    const int gw = cb * NWAVES + F.wave, NGW = ncb * NWAVES, lane = F.lane;
    bf16* WIN = (bf16*)(F.ws + WS_WIN); bf16* WOUT = (bf16*)(F.ws + WS_WOUT); unsigned char* W13 = F.ws + WS_W13; unsigned char* W2 = F.ws + WS_W2;
    struct CJ { const float* src; unsigned char* dst; int ldw, ldd, fp8; float scale; };
#define CW_DECODE(it_, J) do { int r = (it_); \
        if (r < I_IN) { const int l = r / (32 * 96), q = r % (32 * 96), kb = q / 96, nb = q % 96, n0 = nb * 32, k0 = kb * 64; \
            const int dr = n0 < 1024 ? n0 : (n0 < 2048 ? 1024 + 256 * ((n0 - 1024) >> 7) + (n0 & 127) : 1024 + 256 * ((n0 - 2048) >> 7) + 128 + (n0 & 127));     \
            J.src = F.w_in + (size_t)l * D * NZ + (size_t)k0 * NZ + n0; J.ldw = NZ; J.ldd = 2 * D; J.fp8 = 0; J.scale = 1.0f; J.dst = (unsigned char*)(WIN + (size_t)l * NZ * D + (size_t)dr * D + k0); } \
        else if ((r -= I_IN) < I_IN8) { const int l = r / (16 * 128), q = r % (16 * 128), kb = q / 128, nb = q % 128, n0 = 3072 + nb * 32, k0 = kb * 128; \
            J.src = F.w_in + (size_t)l * D * NZ + (size_t)k0 * NZ + n0; J.ldw = NZ; J.ldd = D; J.fp8 = 1; J.scale = 64.0f; J.dst = F.ws + WS_WIN8 + (size_t)l * 4096 * D + (size_t)(n0 - 3072) * D + k0; } \
        else if ((r -= I_IN8) < I_OUT) { const int l = r / (32 * 64), q = r % (32 * 64), kb = q / 64, nb = q % 64, n0 = nb * 32, k0 = kb * 64; \
            J.src = F.w_out + (size_t)l * D * D + (size_t)k0 * D + n0; J.ldw = D; J.ldd = 2 * D; J.fp8 = 0; J.scale = 1.0f; J.dst = (unsigned char*)(WOUT + (size_t)l * D * D + (size_t)n0 * D + k0); } \
        else if ((r -= I_OUT) < 2 * I_G) { const int up = r >= I_G; if (up) r -= I_G; const int le = r / 512, q = r % 512, kb = q / 32, nb = q % 32, n0 = nb * 32, k0 = kb * 128; \
            J.src = (up ? F.w_up : F.w_gate) + (size_t)le * D * DE + (size_t)k0 * DE + n0; J.ldw = DE; J.ldd = D; J.fp8 = 1; J.scale = 64.0f; \
            J.dst = W13 + (size_t)le * 2048 * D + (size_t)(256 * (n0 >> 7) + (up ? 128 : 0) + (n0 & 127)) * D + k0; } \
        else { r -= 2 * I_G; const int le = r / 512, q = r % 512, kb = q / 64, nb = q % 64, n0 = nb * 32, k0 = kb * 128; \
            J.src = F.w_down + (size_t)le * DE * D + (size_t)k0 * D + n0; J.ldw = D; J.ldd = DE; J.fp8 = 1; J.scale = 64.0f; J.dst = W2 + (size_t)le * D * DE + (size_t)n0 * DE + k0; } } while (0)
#define CW_LOAD(J, v) do { const f32x4* sp_ = (const f32x4*)(J.src + (size_t)(lane >> 3) * J.ldw) + (lane & 7); \
        _Pragma("unroll") for (int i = 0; i < 8; ++i) v[i] = *(const f32x4*)((const float*)sp_ + (size_t)(8 * i) * J.ldw); \
        if (J.fp8) { _Pragma("unroll") for (int i = 8; i < 16; ++i) v[i] = *(const f32x4*)((const float*)sp_ + (size_t)(8 * i) * J.ldw); } } while (0)
#define CW_ST(i_) do { const int k_ = 8 * (i_) + (lane >> 3); LAS float* wp_ = scr + k_ * 34 + ((4 * (lane & 7) + 4 * ((i_) >> 1)) & 31); const f32x4 t_ = v_[(i_)] * sc_; \
        *(LAS f32x2*)wp_ = (f32x2){t_.x, t_.y}; *(LAS f32x2*)(wp_ + 2) = (f32x2){t_.z, t_.w}; } while (0)
#define CW_PROC(J, v) do { const f32x4* v_ = v; const float sc_ = J.scale; \
        _Pragma("unroll") for (int i = 0; i < 8; ++i) CW_ST(i); \
        if (J.fp8) { _Pragma("unroll") for (int i = 8; i < 16; ++i) CW_ST(i); } \
        LDS_WAIT(); asm volatile("" ::: "memory"); \
        { const int c = lane & 7; \
          _Pragma("unroll") for (int j = 0; j < 4; ++j) { const int n = (lane >> 3) + 8 * j; \
            if (J.fp8) { const LAS float* sp = scr + (16 * c) * 34 + ((n + 4 * c) & 31); \
                *(v4u*)(J.dst + (size_t)n * J.ldd + 16 * c) = (v4u){pk4_fp8(sp[0 * 34], sp[1 * 34], sp[2 * 34], sp[3 * 34]), pk4_fp8(sp[4 * 34], sp[5 * 34], sp[6 * 34], sp[7 * 34]), pk4_fp8(sp[8 * 34], sp[9 * 34], sp[10 * 34], sp[11 * 34]), pk4_fp8(sp[12 * 34], sp[13 * 34], sp[14 * 34], sp[15 * 34])}; } \
            else { const LAS float* sp = scr + (8 * c) * 34 + ((n + 4 * (c >> 1)) & 31); \
                *(v4u*)(J.dst + (size_t)n * J.ldd + 16 * c) = (v4u){pk2(sp[0 * 34], sp[1 * 34]), pk2(sp[2 * 34], sp[3 * 34]), pk2(sp[4 * 34], sp[5 * 34]), pk2(sp[6 * 34], sp[7 * 34])}; } } } \
        LDS_WAIT(); asm volatile("" ::: "memory"); } while (0)
    CJ ja, jb; f32x4 va[16], vb[16];
    if (q) {
        constexpr int NV2 = I_G + I_D / 2, NV1 = NITEMS - I_IN / 2 - I_IN8 / 2 - NV2, CH = 8;
        const int NV = qsel == 2 ? NV2 : NV1;
#define CW_VIT(v_) cw_vit(qsel, (v_))
        for (int nc = 0; nc < maxc; ++nc) {
            int base = 0; if (lane == 0) base = (int)__hip_atomic_fetch_add(q, (unsigned)CH, __ATOMIC_RELAXED, __HIP_MEMORY_SCOPE_AGENT);
            base = __builtin_amdgcn_readfirstlane(base);
            if (base >= NV) break;
            CW_DECODE(CW_VIT(base), ja); CW_LOAD(ja, va);
#pragma unroll 1
            for (int j = 0; j < CH; j += 2) {
                if (base + j + 1 < NV) { CW_DECODE(CW_VIT(base + j + 1), jb); CW_LOAD(jb, vb); }
                CW_PROC(ja, va);
                if (base + j + 1 >= NV) break;
                if (j + 2 < CH && base + j + 2 < NV) { CW_DECODE(CW_VIT(base + j + 2), ja); CW_LOAD(ja, va); }
                CW_PROC(jb, vb);
                if (base + j + 2 >= NV) break;
            }
        }
#undef CW_VIT
        return;
    }
    int it = it_lo + gw;
    if (it < it_hi) { CW_DECODE(it, ja); CW_LOAD(ja, va); }
    while (it < it_hi) {
        if (it + NGW < it_hi) { CW_DECODE(it + NGW, jb); CW_LOAD(jb, vb); }
        CW_PROC(ja, va);
        it += NGW; if (it >= it_hi) break;
        if (it + NGW < it_hi) { CW_DECODE(it + NGW, ja); CW_LOAD(ja, va); }
        CW_PROC(jb, vb);
        it += NGW;
    }
#undef CW_DECODE
#undef CW_LOAD
#undef CW_ST
#undef CW_PROC
}
__device__ __forceinline__ void p0_prologue(Frame& F, const bool all_weights) {
    const int gw = F.bid * NWAVES + F.wave, NGW = F.G * NWAVES;
    if (all_weights) conv_weights(F, 0, NITEMS, F.bid, F.G);
    else { conv_weights(F, 0, I_IN / 2, F.bid, F.G); conv_weights(F, I_IN, I_IN + I_IN8 / 2, F.bid, F.G); }
    { f32x2* cs = (f32x2*)(F.ws + WS_ROPE);
      for (int i = F.bid * 512 + F.tid; i < SEQ * 64; i += F.G * 512) { const int pos = i >> 6, j = i & 63;
          double inv = 1.0; const double cbase = 0.86596432336006535;
          for (int q = 0; q < j; ++q) inv *= cbase;
          const float ang = (float)pos * (float)inv; float c, s; sincos_d((double)ang, c, s); cs[i] = (f32x2){c, s}; } }
    { v4u* wr = (v4u*)(F.ws + WS_WR);
      for (int i = F.bid * 512 + F.tid; i < NLAYER * 64 * 3 * 2 * 64; i += F.G * 512) {
          const int ln = i & 63, hl = (i >> 6) & 1, q = i >> 7, nt = q % 3, s = (q / 3) % 64, l = q / 192;
          const int n = 16 * nt + (ln & 15); unsigned w[4];
#pragma unroll
          for (int jj = 0; jj < 4; ++jj) { float v[2];
#pragma unroll
              for (int e = 0; e < 2; ++e) { const int k = 32 * s + 8 * (ln >> 4) + 2 * jj + e;
                  float val = 0.f; if (n < 4) val = F.w_group[((size_t)l * D + k) * 4 + n]; else if (n < 36) val = F.w_router[((size_t)l * D + k) * 32 + (n - 4)];
                  val *= F.g_ffn[l * D + k]; const float hi = bf2f((bf16)f2bf(val)); v[e] = hl ? (val - hi) : val; }
              w[jj] = pk2(v[0], v[1]); }
          wr[i] = (v4u){w[0], w[1], w[2], w[3]}; } }
    { bf16* H = (bf16*)(F.ws + WS_H);
      bf16* X1 = (bf16*)(F.ws + WS_X1);
      const f32x4* gr = (const f32x4*)F.g_mix + F.lane;
      f32x4 gq[8];
#pragma unroll
      for (int j = 0; j < 8; ++j) gq[j] = gr[64 * j];
      for (int m = gw; m < T; m += 2 * NGW) {
          f32x4 v[2][8]; float ss[2] = {0.f, 0.f};
#pragma unroll
          for (int r = 0; r < 2; ++r) { const f32x4* xr = (const f32x4*)(F.x + (size_t)(m + r * NGW) * D) + F.lane;
#pragma unroll
              for (int j = 0; j < 8; ++j) v[r][j] = xr[64 * j]; }
#pragma unroll
          for (int r = 0; r < 2; ++r) { const size_t row = (size_t)(m + r * NGW); v2u* xc = (v2u*)(X1 + row * D) + F.lane; v2u* o8 = (v2u*)(H + row * D) + F.lane; unsigned* of8 = (unsigned*)(F.ws + WS_H8 + row * D) + F.lane;
#pragma unroll
              for (int j = 0; j < 8; ++j) { const f32x4 t = v[r][j]; ss[r] += (t.x * t.x + t.y * t.y) + (t.z * t.z + t.w * t.w); xc[64 * j] = (v2u){pk2(t.x, t.y), pk2(t.z, t.w)}; }
              const float rstd = __builtin_amdgcn_rsqf(wave_sum(ss[r], F.lane) * (1.0f / D) + EPS);
#pragma unroll
              for (int j = 0; j < 8; ++j) { const f32x4 gv = gq[j]; const f32x4 hv = v[r][j] * rstd * gv; v2u o; o.x = pk2(hv.x, hv.y); o.y = pk2(hv.z, hv.w); o8[64 * j] = o; of8[64 * j] = pk4_fp8(hv.x, hv.y, hv.z, hv.w); } } } }
}

typedef short s16x4 __attribute__((ext_vector_type(4)));
__device__ __forceinline__ f32x16 mfma32(bf16x8 a, bf16x8 b, f32x16 c) { return __builtin_amdgcn_mfma_f32_32x32x16_bf16(a, b, c, 0, 0, 0); }
constexpr int PR = 272, PT = 320;
constexpr int RQ = 0, RK = RQ + 64 * PR, RKD = RK + 64 * PR, RV = RKD + 64 * PT, RRT = RV + 64 * PT, RSF = RRT + 128 * PR, RSQ = RSF + 8192, R_END = RSQ + 1024;
static_assert(R_END <= MISC_OFF, "retention LDS");
__device__ __forceinline__ s16x4 trr(const LAS unsigned char* a) { return __builtin_amdgcn_ds_read_tr16_b64_v4i16((LAS s16x4*)a); }
__device__ __forceinline__ bf16x8 cat8(s16x4 a, s16x4 b) { return (bf16x8){a.x, a.y, a.z, a.w, b.x, b.y, b.z, b.w}; }
struct RetPre { v4u q1, q2, k1, k2, v1, v2; f32x4 cs[4]; };
__device__ __forceinline__ void ret_load(RetPre& P, const bf16* zr, const f32x2* csrow, int h, int part) {
    const int j0 = 8 * part;
    P.q1 = *(const v4u*)(zr + 3072 + HD * h + j0); P.q2 = *(const v4u*)(zr + 3072 + HD * h + 64 + j0);
    P.k1 = *(const v4u*)(zr + 4096 + HD * h + j0); P.k2 = *(const v4u*)(zr + 4096 + HD * h + 64 + j0);
    P.v1 = *(const v4u*)(zr + 5120 + HD * h + 16 * part); P.v2 = *(const v4u*)(zr + 5120 + HD * h + 16 * part + 8);
    (void)csrow;
}
__device__ __forceinline__ void ret_load_cs(RetPre& P, const f32x2* csrow, int part) {
    const f32x4* csp = (const f32x4*)(csrow + 8 * part);
#pragma unroll
    for (int p = 0; p < 4; ++p) P.cs[p] = csp[p];
}
__device__ __forceinline__ void ret_write(const RetPre& P, LAS unsigned char* wr, LAS unsigned char* wt, float kd) {
    float ql[8], qh[8], kl[8], kh[8];
#pragma unroll
    for (int p = 0; p < 4; ++p) { const f32x4 c4 = P.cs[p];
#pragma unroll
        for (int e = 0; e < 2; ++e) { const int jj = 2 * p + e; const float c = e ? c4.z : c4.x, s = e ? c4.w : c4.y;
            const float a = e ? bfhi(P.q1[p]) : bflo(P.q1[p]), bb = e ? bfhi(P.q2[p]) : bflo(P.q2[p]);
            ql[jj] = a * c - bb * s; qh[jj] = bb * c + a * s;
            const float ka = e ? bfhi(P.k1[p]) : bflo(P.k1[p]), kb = e ? bfhi(P.k2[p]) : bflo(P.k2[p]);
            kl[jj] = (ka * c - kb * s) * 0.08838834764831845f; kh[jj] = (kb * c + ka * s) * 0.08838834764831845f; } }
    *(LAS v4u*)(wr + RQ) = (v4u){pk2(ql[0], ql[1]), pk2(ql[2], ql[3]), pk2(ql[4], ql[5]), pk2(ql[6], ql[7])};
    *(LAS v4u*)(wr + RQ + 128) = (v4u){pk2(qh[0], qh[1]), pk2(qh[2], qh[3]), pk2(qh[4], qh[5]), pk2(qh[6], qh[7])};
    *(LAS v4u*)(wr + RK) = (v4u){pk2(kl[0], kl[1]), pk2(kl[2], kl[3]), pk2(kl[4], kl[5]), pk2(kl[6], kl[7])};
    *(LAS v4u*)(wr + RK + 128) = (v4u){pk2(kh[0], kh[1]), pk2(kh[2], kh[3]), pk2(kh[4], kh[5]), pk2(kh[6], kh[7])};
    *(LAS v4u*)(wt + RKD) = (v4u){pk2(kl[0] * kd, kl[1] * kd), pk2(kl[2] * kd, kl[3] * kd), pk2(kl[4] * kd, kl[5] * kd), pk2(kl[6] * kd, kl[7] * kd)};
    *(LAS v4u*)(wt + RKD + 128) = (v4u){pk2(kh[0] * kd, kh[1] * kd), pk2(kh[2] * kd, kh[3] * kd), pk2(kh[4] * kd, kh[5] * kd), pk2(kh[6] * kd, kh[7] * kd)};
}
__device__ __forceinline__ void retention_unit(Frame& F, const bf16* Z, bf16* Y, int b, int h) {
    const int tid = F.tid, lane = F.lane, wid = F.wave, l31 = lane & 31, lh = lane >> 5;
    LAS unsigned char* L = F.lds;
    const float xg = __builtin_amdgcn_exp2f(-(float)(5 + h));
    const float lng = -(xg + xg * xg * 0.5f + xg * xg * xg * (1.0f / 3.0f) + xg * xg * xg * xg * 0.25f + xg * xg * xg * xg * xg * 0.2f + xg * xg * xg * xg * xg * xg * (1.0f / 6.0f));
    const float lg2 = lng * 1.4426950408889634f;
    const float cd = __builtin_amdgcn_exp2f(lg2 * 64.0f);
    const f32x2* CS = (const f32x2*)(F.ws + WS_ROPE);
    const int li = tid >> 3, part = tid & 7;
    const float kd = __builtin_amdgcn_exp2f(lg2 * (float)(63 - li));
    LAS unsigned char* const wr = L + li * PR + 16 * part; LAS unsigned char* const wt = L + li * PT + 16 * part; LAS unsigned char* const wv = L + RV + li * PT + 32 * part;
    const int ote = wid >> 1, oti = wid & 1;
    const float qdec = __builtin_amdgcn_exp2f(lg2 * (float)(32 * oti + l31 + 1));
    const LAS unsigned char* const rrow = L + l31 * PR + 16 * lh;
    const int q4 = (lane & 15) >> 2, p4 = lane & 3, blk = (lane >> 4) & 1;
    const LAS unsigned char* const tr8 = L + (q4 + 8 * lh) * PT + 32 * blk + 8 * p4;
    const LAS unsigned char* const tr4 = L + (q4 + 4 * lh) * PT + 32 * blk + 8 * p4;
    f32x16 st[4];
#pragma unroll
    for (int t = 0; t < 4; ++t)
#pragma unroll
        for (int r = 0; r < 16; ++r) st[t][r] = 0.f;
    const bf16* zbase = Z + (size_t)(b * SEQ) * NZ;
    RetPre P;
    ret_load(P, zbase + (size_t)li * NZ, CS + (size_t)li * 64, h, part); ret_load_cs(P, CS + (size_t)li * 64, part);
    ret_write(P, wr, wt, kd); *(LAS v4u*)(wv) = P.v1; *(LAS v4u*)(wv + 16) = P.v2;
    ret_load(P, zbase + (size_t)(CHUNK + li) * NZ, CS + (size_t)(CHUNK + li) * 64, h, part);
    { int lm = lane; asm volatile("" : "+v"(lm) :: "memory");
      if (wid < 4) { const int tj = wid >> 1, ti = wid & 1, l31m = lm & 31, lhm = lm >> 5;
#pragma unroll
        for (int r = 0; r < 16; ++r) { const int j = 32 * tj + (r & 3) + 8 * (r >> 2) + 4 * lhm, i = 32 * ti + l31m; st[0][r] = __builtin_amdgcn_exp2f(lg2 * (float)(i > j ? i - j : j - i)); } } }
    unsigned op[8]; v2u gz[4];
#define RET_FINALIZE(tq) do { const f32x4 q4v = *(const LAS f32x4*)(L + RSQ + (32 * oti + l31) * 16); \
          const float rs = __builtin_amdgcn_rsqf(((q4v.x + q4v.y) + (q4v.z + q4v.w)) * (1.0f / HD) + EPS); \
          bf16* yp = Y + (size_t)((tq) + 32 * oti + l31) * D + 1024 + HD * h + 32 * ote + 4 * lh; \
          _Pragma("unroll") for (int g = 0; g < 4; ++g) { float o4[4]; \
              _Pragma("unroll") for (int e = 0; e < 4; ++e) { const unsigned gw = e < 2 ? gz[g].x : gz[g].y; const float gv = (e & 1) ? bfhi(gw) : bflo(gw); const unsigned ow = op[2 * g + (e >> 1)]; const float ov = (e & 1) ? bfhi(ow) : bflo(ow); o4[e] = ov * rs * gv * __builtin_amdgcn_rcpf(1.0f + __expf(-gv)); } \
              *(v2u*)(yp + 8 * g) = (v2u){pk2(o4[0], o4[1]), pk2(o4[2], o4[3])}; } } while (0)
    __syncthreads();
    for (int n = 0; n < SEQ / CHUNK; ++n) {
        const int t0 = b * SEQ + n * CHUNK;
        if (n + 1 < SEQ / CHUNK) ret_load_cs(P, CS + (size_t)((n + 1) * CHUNK + li) * 64, part);
        if (wid < 4) {
            const int tj = wid >> 1, ti = wid & 1; f32x16 x;
            const LAS unsigned char* ka = rrow + RK + tj * (32 * PR); const LAS unsigned char* qa = rrow + RQ + ti * (32 * PR);
#pragma unroll
            for (int r = 0; r < 16; ++r) x[r] = 0.f;
#pragma unroll
            for (int s = 0; s < 8; ++s) x = mfma32(*(const LAS bf16x8*)(ka + 32 * s), *(const LAS bf16x8*)(qa + 32 * s), x);
#pragma unroll
            for (int s = 0; s < 2; ++s) { v4u f;
                f.x = pk2(x[8 * s + 0] * st[0][8 * s + 0], x[8 * s + 1] * st[0][8 * s + 1]); f.y = pk2(x[8 * s + 2] * st[0][8 * s + 2], x[8 * s + 3] * st[0][8 * s + 3]);
                f.z = pk2(x[8 * s + 4] * st[0][8 * s + 4], x[8 * s + 5] * st[0][8 * s + 5]); f.w = pk2(x[8 * s + 6] * st[0][8 * s + 6], x[8 * s + 7] * st[0][8 * s + 7]);
                *(LAS v4u*)(L + RSF + ((wid * 2 + s) * 64 + lane) * 16) = f; }
        } else {
            const int te = wid - 4;
            LAS unsigned char* rtw = L + RRT + (32 * te + l31) * PR + 8 * lh;
#pragma unroll
            for (int td = 0; td < 4; ++td)
#pragma unroll
                for (int g = 0; g < 4; ++g) { v2u w; w.x = pk2(st[td][4 * g + 0], st[td][4 * g + 1]); w.y = pk2(st[td][4 * g + 2], st[td][4 * g + 3]);
                    *(LAS v2u*)(rtw + 64 * td + 16 * g) = w; }
#pragma unroll
            for (int td = 0; td < 4; ++td)
#pragma unroll
                for (int r = 0; r < 16; ++r) st[td][r] *= cd;
            const LAS unsigned char* va = tr8 + RV + 64 * te; const LAS unsigned char* kda = tr8 + RKD;
#pragma unroll
            for (int s = 0; s < 4; ++s) { const bf16x8 bv = cat8(trr(va + (16 * s) * PT), trr(va + (16 * s + 4) * PT));
#pragma unroll
                for (int td = 0; td < 4; ++td) st[td] = mfma32(cat8(trr(kda + (16 * s) * PT + 64 * td), trr(kda + (16 * s + 4) * PT + 64 * td)), bv, st[td]); }
        }
        if (n > 0) RET_FINALIZE(t0 - CHUNK);
        __syncthreads();
        f32x16 oi, oc;
#pragma unroll
        for (int r = 0; r < 16; ++r) { oi[r] = 0.f; oc[r] = 0.f; }
        { const LAS unsigned char* va = tr4 + RV + 64 * ote; const LAS unsigned char* sf = L + RSF + (oti * 2 * 64 + lane) * 16;
#pragma unroll
          for (int tj = 0; tj < 2; ++tj)
#pragma unroll
            for (int s = 0; s < 2; ++s) { const bf16x8 xb = *(const LAS bf16x8*)(sf + (tj * 2 * 2 + s) * 1024);
                oi = mfma32(cat8(trr(va + (32 * tj + 16 * s) * PT), trr(va + (32 * tj + 16 * s + 8) * PT)), xb, oi); } }
        { const LAS unsigned char* ra = rrow + RRT + ote * (32 * PR); const LAS unsigned char* qa = rrow + RQ + oti * (32 * PR);
#pragma unroll
          for (int s = 0; s < 8; ++s) oc = mfma32(*(const LAS bf16x8*)(ra + 32 * s), *(const LAS bf16x8*)(qa + 32 * s), oc); }
        float sq = 0.f;
#pragma unroll
        for (int r = 0; r < 16; ++r) { oi[r] += qdec * oc[r]; sq += oi[r] * oi[r]; }
        sq += shx(sq, 32, lane);
        if (lane < 32) *(LAS float*)(L + RSQ + ((32 * oti + l31) * 4 + ote) * 4) = sq;
#pragma unroll
        for (int r = 0; r < 8; ++r) op[r] = pk2(oi[2 * r], oi[2 * r + 1]);
        __syncthreads();
        { const bf16* gp = Z + (size_t)(t0 + 32 * oti + l31) * NZ + 6144 + HD * h + 32 * ote + 4 * lh;
#pragma unroll
          for (int g = 0; g < 4; ++g) gz[g] = *(const v2u*)(gp + 8 * g); }
        if (n + 1 < SEQ / CHUNK) { ret_write(P, wr, wt, kd); *(LAS v4u*)(wv) = P.v1; *(LAS v4u*)(wv + 16) = P.v2; }
        if (n + 2 < SEQ / CHUNK) ret_load(P, zbase + (size_t)((n + 2) * CHUNK + li) * NZ, CS + (size_t)((n + 2) * CHUNK + li) * 64, h, part);
        __syncthreads();
    }
    RET_FINALIZE(b * SEQ + SEQ - CHUNK);
#undef RET_FINALIZE
}
__device__ __forceinline__ void conv_items(Frame& F, int l, const bf16* Z, bf16* Y, int cb, int ncb) {
    const float* cw = F.conv_w + (size_t)l * 3 * 1024;
    for (int it = cb * 512 + F.tid; it < (T / 16) * 128; it += ncb * 512) {
        const int tb = (it >> 7) * 16, c0 = 8 * (it & 127);
        float w[3][8];
#pragma unroll
        for (int k = 0; k < 3; ++k) { const f32x4 a = *(const f32x4*)(cw + k * 1024 + c0), b2 = *(const f32x4*)(cw + k * 1024 + c0 + 4);
            w[k][0] = a.x; w[k][1] = a.y; w[k][2] = a.z; w[k][3] = a.w; w[k][4] = b2.x; w[k][5] = b2.y; w[k][6] = b2.z; w[k][7] = b2.w; }
        float u1[8], u2[8];
#pragma unroll
        for (int p = 0; p < 8; ++p) { u1[p] = 0.f; u2[p] = 0.f; }
        if ((tb & (SEQ - 1)) != 0) {
#pragma unroll
            for (int d = 1; d <= 2; ++d) { const bf16* zr = Z + (size_t)(tb - d) * NZ; const v4u ug = *(const v4u*)(zr + 1024 + c0);
#pragma unroll
                for (int p = 0; p < 4; ++p) { const float lo = bflo(ug[p]), hi = bfhi(ug[p]); if (d == 1) { u1[2 * p] = lo; u1[2 * p + 1] = hi; } else { u2[2 * p] = lo; u2[2 * p + 1] = hi; } } }
        }
#pragma unroll 4
        for (int tt = 0; tt < 16; ++tt) { const bf16* zr = Z + (size_t)(tb + tt) * NZ;
            const v4u bg = *(const v4u*)(zr + c0), ug = *(const v4u*)(zr + 1024 + c0);
            float u0[8], o[8];
#pragma unroll
            for (int p = 0; p < 4; ++p) { u0[2 * p] = bflo(ug[p]); u0[2 * p + 1] = bfhi(ug[p]); }
#pragma unroll
            for (int p = 0; p < 8; ++p) { const float bgv = (p & 1) ? bfhi(bg[p >> 1]) : bflo(bg[p >> 1]); o[p] = bgv * (w[0][p] * u2[p] + w[1][p] * u1[p] + w[2][p] * u0[p]); u2[p] = u1[p]; u1[p] = u0[p]; }
            *(v4u*)(Y + (size_t)(tb + tt) * D + c0) = (v4u){pk2(o[0], o[1]), pk2(o[2], o[3]), pk2(o[4], o[5]), pk2(o[6], o[7])}; }
    }
}

__device__ __forceinline__ void router_phase(Frame& F, int l, int cw) {
    const int tid = F.tid, lane = F.lane, wid = F.wave, r16 = lane & 15, g4 = lane >> 4;
    LAS unsigned char* L = F.lds;
    LAS float* part = (LAS float*)L;
    LAS int* sel = (LAS int*)(L + 50688); LAS int* hist = (LAS int*)(L + 53248); LAS int* baseS = (LAS int*)(L + 53376); LAS int* rank = (LAS int*)(L + 53760);
    const bf16* X1 = (const bf16*)(F.ws + WS_X1); unsigned char* H8 = F.ws + WS_H8;
    const v4u* WR = (const v4u*)(F.ws + WS_WR) + (size_t)l * (64 * 3 * 2 * 64);
    const float* gff = F.g_ffn + l * D;
    int* list = (int*)(F.ws + WS_LIST); i32x4* info = (i32x4*)(F.ws + WS_INFO);
    unsigned* cntg = F.ctl + cw + 32 * l;
    LAS float* gffL = (LAS float*)(L + 61440); LAS float* lgA = (LAS float*)(L + 69632); LAS float* ssqA = (LAS float*)(L + 94208);
    *(LAS f32x4*)(gffL + 4 * tid) = *(const f32x4*)(gff + 4 * tid);
    for (int grp = F.bid; grp < T / 128; grp += F.G) {
        { int lh_ = lane; asm volatile("" : "+v"(lh_)); if (wid == 0 && lh_ < 32) hist[lh_] = 0; }
#pragma unroll 1
        for (int si = 0; si < 4; ++si) {
            const int r0 = grp * 128 + si * 32;
            LAS float* ssqs = ssqA + si * 256; LAS float* lgs = lgA + si * (32 * 48);
            v4u xb[2][8];
            int ln1 = lane; asm volatile("" : "+v"(ln1));
#pragma unroll
            for (int f = 0; f < 2; ++f) { const bf16* xr = X1 + (size_t)(r0 + 16 * f + (ln1 & 15)) * D + 256 * wid + 8 * (ln1 >> 4);
#pragma unroll
                for (int ks = 0; ks < 8; ++ks) xb[f][ks] = *(const v4u*)(xr + 32 * ks); }
            f32x4 acc[2][3]; float ss[2] = {0.f, 0.f};
#pragma unroll
            for (int f = 0; f < 2; ++f)
#pragma unroll
                for (int nt = 0; nt < 3; ++nt) acc[f][nt] = (f32x4){0.f, 0.f, 0.f, 0.f};
            v4u wfa[8][3];
#pragma unroll
            for (int kb = 0; kb < 8; ++kb) { const v4u* wp = WR + ((size_t)((8 * wid + kb) * 3) * 2) * 64 + ln1;
#pragma unroll
                for (int nt = 0; nt < 3; ++nt) wfa[kb][nt] = wp[nt * 128]; }
            asm volatile("" ::: "memory");
#pragma unroll
            for (int kb = 0; kb < 8; ++kb) {
                v4u wf[1][6];
#pragma unroll
                for (int nt = 0; nt < 3; ++nt) wf[0][nt * 2] = wfa[kb][nt];
#pragma unroll
                for (int k4 = 0; k4 < 1; ++k4) { const int ks = kb + k4;
#pragma unroll
                    for (int f = 0; f < 2; ++f) { const bf16x8 ah = __builtin_bit_cast(bf16x8, xb[f][ks]);
#pragma unroll
                        for (int p = 0; p < 4; ++p) { const float lo = bflo(xb[f][ks][p]), hi = bfhi(xb[f][ks][p]); ss[f] += lo * lo + hi * hi; }
#pragma unroll
                        for (int nt = 0; nt < 3; ++nt) { const bf16x8 bh = __builtin_bit_cast(bf16x8, wf[k4][nt * 2 + 0]);
                            acc[f][nt] = __builtin_amdgcn_mfma_f32_16x16x32_bf16(ah, bh, acc[f][nt], 0, 0, 0); } } }
            }
#pragma unroll
            for (int f = 0; f < 2; ++f) {
#pragma unroll
                for (int nt = 0; nt < 3; ++nt)
#pragma unroll
                    for (int rg = 0; rg < 4; ++rg) part[(wid * 32 + 16 * f + 4 * g4 + rg) * 48 + 16 * nt + r16] = acc[f][nt][rg];
                float q = ss[f]; q += shx(q, 16, lane); q += shx(q, 32, lane);
                if (lane < 16) ssqs[wid * 32 + 16 * f + lane] = q; }
            __syncthreads();
            int ln2 = lane; asm volatile("" : "+v"(ln2));
            const int r16 = ln2 & 15, g4 = ln2 >> 4, tid = wid * 64 + ln2;
#pragma unroll
            for (int f = 0; f < 2; ++f) { float q = 0.f;
#pragma unroll
              for (int w = 0; w < 8; ++w) q += ssqs[w * 32 + 16 * f + r16];
              const float rstd = __builtin_amdgcn_rsqf(q * (1.0f / D) + EPS); unsigned char* hr = H8 + (size_t)(r0 + 16 * f + r16) * D + 256 * wid + 8 * g4; const LAS float* gp = gffL + 256 * wid + 8 * g4;
#pragma unroll
              for (int ks = 0; ks < 8; ++ks) { const f32x4 g0 = *(const LAS f32x4*)(gp + 32 * ks), g1 = *(const LAS f32x4*)(gp + 32 * ks + 4); const v4u xx = xb[f][ks];
                  const f32x4 a = (f32x4){bflo(xx.x), bfhi(xx.x), bflo(xx.y), bfhi(xx.y)} * rstd * g0, b2 = (f32x4){bflo(xx.z), bfhi(xx.z), bflo(xx.w), bfhi(xx.w)} * rstd * g1;
                  *(v2u*)(hr + 32 * ks) = (v2u){pk4_fp8(a.x, a.y, a.z, a.w), pk4_fp8(b2.x, b2.y, b2.z, b2.w)}; } }
            for (int idx = tid; idx < 32 * 48; idx += 512) { const int row = idx / 48, n = idx - row * 48; float a = 0.f;
#pragma unroll
                for (int w = 0; w < 8; ++w) a += part[(w * 32 + row) * 48 + n];
                lgs[idx] = a; }
            __syncthreads();
        }
        int lx = lane; asm volatile("" : "+v"(lx)); const int ts = wid * 64 + lx;
        if (ts < 128) {
                const int tid = ts, si = tid >> 5, tr = tid & 31; const LAS float* ssqs = ssqA + si * 256;
                float q = 0.f;
#pragma unroll
                for (int w = 0; w < 8; ++w) q += ssqs[w * 32 + tr];
                const float rstd = 1.0f / sqrtf(q * (1.0f / D) + EPS);
                const LAS float* lg = lgA + tid * 48; const float* bg = F.b_group + l * 4; const float* br = F.b_router + l * 32;
                int gs = 0; float gm = lg[0] * rstd + bg[0];
#pragma unroll
                for (int n = 1; n < 4; ++n) { const float v = lg[n] * rstd + bg[n]; if (v > gm) { gm = v; gs = n; } }
                float den = 0.f;
#pragma unroll
                for (int n = 0; n < 4; ++n) den += __expf(lg[n] * rstd + bg[n] - gm);
                const float pg = 1.0f / den;
                int i1 = 0; float m1 = lg[4 + 8 * gs] * rstd + br[8 * gs];
#pragma unroll
                for (int n = 1; n < 8; ++n) { const float v = lg[4 + 8 * gs + n] * rstd + br[8 * gs + n]; if (v > m1) { m1 = v; i1 = n; } }
                int i2 = -1; float m2 = 0.f;
#pragma unroll
                for (int n = 0; n < 8; ++n) { const float v = lg[4 + 8 * gs + n] * rstd + br[8 * gs + n]; if (n != i1 && (i2 < 0 || v > m2)) { m2 = v; i2 = n; } }
                const float ex = __expf(m2 - m1), s1 = 1.0f / (1.0f + ex), s2 = ex / (1.0f + ex);
                const int tl = tid;
                sel[tl * 4 + 0] = gs * 8 + i1; sel[tl * 4 + 1] = gs * 8 + i2; sel[tl * 4 + 2] = __builtin_bit_cast(int, pg * s1); sel[tl * 4 + 3] = __builtin_bit_cast(int, pg * s2);
        }
        __syncthreads();
        int ly = lane; asm volatile("" : "+v"(ly)); const int td = wid * 64 + ly;
        int e_my = 0;
        if (td < 256) { e_my = sel[(td >> 1) * 4 + (td & 1)]; rank[td] = atomicAdd((int*)&hist[e_my], 1); }
        __syncthreads();
        if (td < 32) baseS[td] = (int)xb_add(cntg + td, (unsigned)hist[td]);
        __syncthreads();
        if (td < 256) { const int tok = grp * 128 + (td >> 1), slot = baseS[e_my] + rank[td];
            list[(size_t)e_my * T + slot] = tok;
            int* ip = (int*)(info + tok); ip[td & 1] = (e_my << 16) | slot; ip[2 + (td & 1)] = sel[(td >> 1) * 4 + 2 + (td & 1)]; }
        __syncthreads();
    }
}
__device__ __forceinline__ void moe_tables(Frame& F, int l) {
    LAS int* tstart = (LAS int*)(F.MISC + MW_TSTART); LAS int* cnt = (LAS int*)(F.MISC + MW_CNT); LAS int* tile_e = (LAS int*)(F.MISC + MW_TILE);
    __syncthreads();
    if (F.tid < 32) cnt[F.tid] = (int)xb_ld(F.ctl + CW_CNT + 32 * l + F.tid);
    __syncthreads();
    if (F.tid == 0) { int a = 0; for (int e = 0; e < NE; ++e) { tstart[e] = a; int c = cnt[e]; c = c < 0 ? 0 : (c > T ? T : c); a += (c + 255) >> 8; } tstart[NE] = a; }
    __syncthreads();
    for (int rt = F.tid; rt < MAXTILES + 8; rt += 512) { int e = 0; for (int q = 1; q < NE; ++q) if (tstart[q] <= rt) e = q; tile_e[rt] = e; }
    __syncthreads();
}
__device__ __forceinline__ void combine_phase(Frame& F, int l) {
    const LAS int* tstart = (const LAS int*)(F.MISC + MW_TSTART);
    const int gw = F.bid * NWAVES + F.wave, NGW = F.G * NWAVES, lane = F.lane;
    bf16* X1 = (bf16*)(F.ws + WS_X1); const unsigned char* YB = F.ws + WS_YB; bf16* H = (bf16*)(F.ws + WS_H);
    const i32x4* info = (const i32x4*)(F.ws + WS_INFO);
    const float* g = (l + 1 < NLAYER) ? F.g_mix + (l + 1) * D : F.g_final;
    const f32x4* gr = (const f32x4*)g + lane;
    f32x4 gq[8];
#pragma unroll
    for (int j = 0; j < 8; ++j) gq[j] = gr[64 * j];
    i32x4 infn[2]; infn[0] = info[gw]; infn[1] = info[gw + NGW];
    for (int t = gw; t < T; t += 2 * NGW) {
        i32x4 inf[2]; inf[0] = infn[0]; inf[1] = infn[1];
        if (t + 2 * NGW < T) { infn[0] = info[t + 2 * NGW]; infn[1] = info[t + 3 * NGW]; }
        v2u xq[2][8]; unsigned ya[2][8], yb[2][8]; float wa[2], wb[2];
#pragma unroll
        for (int r = 0; r < 2; ++r) { const int tt = t + r * NGW;
            const int ra = 256 * tstart[inf[r].x >> 16] + (inf[r].x & 0xffff), rb = 256 * tstart[inf[r].y >> 16] + (inf[r].y & 0xffff);
            const int wai = inf[r].z, wbi = inf[r].w; wa[r] = __int_as_float(wai); wb[r] = __int_as_float(wbi);
            const v2u* xr = (const v2u*)(X1 + (size_t)tt * D) + lane; const unsigned* pa = (const unsigned*)(YB + (size_t)ra * D) + lane; const unsigned* pb = (const unsigned*)(YB + (size_t)rb * D) + lane;
#pragma unroll
            for (int j = 0; j < 8; ++j) { xq[r][j] = xr[64 * j]; ya[r][j] = pa[64 * j]; yb[r][j] = pb[64 * j]; } }
#pragma unroll
        for (int r = 0; r < 2; ++r) { const int tt = t + r * NGW; f32x4 v[8]; float s = 0.f;
#pragma unroll
            for (int j = 0; j < 8; ++j) { const f32x4 xv = (f32x4){bflo(xq[r][j].x), bfhi(xq[r][j].x), bflo(xq[r][j].y), bfhi(xq[r][j].y)}; const unsigned a = ya[r][j], b2 = yb[r][j];
                const f32x2 a01 = __builtin_amdgcn_cvt_pk_f32_fp8((int)a, false), a23 = __builtin_amdgcn_cvt_pk_f32_fp8((int)a, true), b01 = __builtin_amdgcn_cvt_pk_f32_fp8((int)b2, false), b23 = __builtin_amdgcn_cvt_pk_f32_fp8((int)b2, true);
                v[j].x = xv.x + wa[r] * a01.x + wb[r] * b01.x; v[j].y = xv.y + wa[r] * a01.y + wb[r] * b01.y; v[j].z = xv.z + wa[r] * a23.x + wb[r] * b23.x; v[j].w = xv.w + wa[r] * a23.y + wb[r] * b23.y;
                s += (v[j].x * v[j].x + v[j].y * v[j].y) + (v[j].z * v[j].z + v[j].w * v[j].w); }
            const float rstd = 1.0f / sqrtf(wave_sum(s, lane) * (1.0f / D) + EPS);
            if (l + 1 < NLAYER) { v2u* xo = (v2u*)(X1 + (size_t)tt * D) + lane; v2u* ho = (v2u*)(H + (size_t)tt * D) + lane; unsigned* ho8 = (unsigned*)(F.ws + WS_H8 + (size_t)tt * D) + lane;
#pragma unroll
                for (int j = 0; j < 8; ++j) { xo[64 * j] = (v2u){pk2(v[j].x, v[j].y), pk2(v[j].z, v[j].w)}; const f32x4 gv = gq[j]; const f32x4 hv = v[j] * rstd * gv; v2u o; o.x = pk2(hv.x, hv.y); o.y = pk2(hv.z, hv.w); ho[64 * j] = o; ho8[64 * j] = pk4_fp8(hv.x, hv.y, hv.z, hv.w); } }
            else { f32x4* oo = (f32x4*)(F.out + (size_t)tt * D) + lane;
#pragma unroll
                for (int j = 0; j < 8; ++j) { const f32x4 gv = gq[j]; oo[64 * j] = v[j] * rstd * gv; } } }
    }
}

struct Args { const float* in[14]; float* out; unsigned char* ws; int ph_lo, ph_hi; };
__global__ void __launch_bounds__(NWAVES * 64, 2) mk_fwd(Args args) {
    extern __shared__ __attribute__((aligned(16))) unsigned char lds[];
    Frame F;
    F.lds = (LAS unsigned char*)lds; F.MISC = (volatile LAS unsigned*)(F.lds + MISC_OFF);
    F.tid = threadIdx.x; F.lane = F.tid & 63; F.wave = __builtin_amdgcn_readfirstlane(F.tid >> 6); F.G = gridDim.x; F.bid = blockIdx.x;
    F.ws = args.ws; F.ctl = (unsigned*)(args.ws + WS_CTL); F.out = args.out;
    F.x = args.in[0]; F.g_mix = args.in[1]; F.w_in = args.in[2]; F.conv_w = args.in[3]; F.w_out = args.in[4]; F.g_ffn = args.in[5]; F.w_group = args.in[6]; F.b_group = args.in[7];
    F.w_router = args.in[8]; F.b_router = args.in[9]; F.w_gate = args.in[10]; F.w_up = args.in[11]; F.w_down = args.in[12]; F.g_final = args.in[13];
    for (int u = F.tid; u < (LDS_BYTES - MISC_OFF) / 4; u += NWAVES * 64) ((LAS unsigned*)(F.lds + MISC_OFF))[u] = 0u;
    __syncthreads();
    XcdBarrier bar; bar.bar = F.ctl + CW_BAR; bar.x = 0; bar.st = nullptr;
#if !MK_PER_PHASE
    bar = xcd_barrier_post(F.ctl + CW_BAR, F.MISC + MW_BAR);
#endif
    const int lo = args.ph_lo, hi = args.ph_hi;
#define REFRESH() do { unsigned m_ = ~0u; asm volatile("" : "+s"(m_)); int l_ = (int)__builtin_amdgcn_mbcnt_hi(m_, __builtin_amdgcn_mbcnt_lo(m_, 0u)); F.lane = l_; F.tid = F.wave * 64 + l_; } while (0)
#define IN(k) (!MK_PER_PHASE || (lo <= (k) && (k) < hi))
#define DUP(k) ((DUP_MASK >> (k)) & 1)
#define SEAM(k) do { if (IN(k) && IN((k) + 1)) xcd_barrier(bar); } while (0)
    bf16* Hb = (bf16*)(F.ws + WS_H); bf16* Zb = (bf16*)(F.ws + WS_Z); bf16* Yb = (bf16*)(F.ws + WS_Y); bf16* X1 = (bf16*)(F.ws + WS_X1);
    unsigned char* HID = F.ws + WS_HID; unsigned char* YBb = F.ws + WS_YB;

    if (IN(0)) { for (int rep = 0; rep <= DUP(0); ++rep) { if (rep) xcd_barrier(bar); REFRESH(); p0_prologue(F, F.G != 256); } } SEAM(0);
    for (int l = 0; l < NLAYER; ++l) {
        const int pb = 1 + 7 * l;
        if (IN(pb + 0)) {
            const bool side = (l == 0 && F.G == 256);
            constexpr int NCV = NCV_SET;
            if (side && F.bid < NCV) { REFRESH(); conv_weights(F, 0, 0, 0, 1, F.ctl + CW_Q); }
            else { const int gG = side ? F.G - NCV : F.G, gc = side ? F.bid - NCV : F.bid;
            { pg8::DenseOrder S{T / 256, 12, gG, gc, 2 * D, (const char*)Hb, (const char*)(F.ws + WS_WIN) + (size_t)l * NZ * D * 2};
              pg8::EpiConvIn E{Zb, NZ};
              pg8::gemm_phase<pg8::EpiConvIn, pg8::DenseOrder>(F.lds, 2 * D, S, E, F.wave); }
            { pg8::DenseOrder S{T / 256, 16, gG, gc, D, (const char*)(F.ws + WS_H8), (const char*)(F.ws + WS_WIN8) + (size_t)l * 4096 * D};
              pg8::EpiBf16 E{Zb, NZ, 3072};
              pg8::gemm_phase<pg8::EpiBf16, pg8::DenseOrder, true>(F.lds, D, S, E, F.wave); }
            if (side) { REFRESH(); conv_weights(F, 0, 0, 0, 1, F.ctl + CW_Q); } }
        } SEAM(pb + 0);
        if (IN(pb + 1)) {
            for (int rep = 0; rep <= DUP(2); ++rep) { if (rep) xcd_barrier(bar);
            REFRESH();
            for (int u = F.bid; u < 128; u += F.G) retention_unit(F, Zb, Yb, u >> 3, u & 7);
            const bool split = F.G >= 256;
            REFRESH();
            if (!split || F.bid >= 128) conv_items(F, l, Zb, Yb, split ? F.bid - 128 : F.bid, split ? F.G - 128 : F.G);
            if (F.G == 256 && F.bid >= 128) { REFRESH(); conv_weights(F, 0, 0, 0, 1, F.ctl + CW_Q2, 2, l == 0 ? P2_CHUNKS : 0x7fffffff); } }
        } SEAM(pb + 1);
        if (IN(pb + 2)) {
            pg8::DenseOrder S{T / 256, D / 256, F.G, F.bid, 2 * D, (const char*)Yb, (const char*)(F.ws + WS_WOUT) + (size_t)l * D * D * 2};
            pg8::EpiResid E{X1, D};
            for (int rep = 0; rep <= 0; ++rep) { if (rep) xcd_barrier(bar); pg8::gemm_phase<pg8::EpiResid, pg8::DenseOrder>(F.lds, 2 * D, S, E, F.wave); }
        } SEAM(pb + 2);
        if (IN(pb + 3)) { if (DUP(4)) { REFRESH(); router_phase(F, l, CW_CNT + 64); xcd_barrier(bar); } REFRESH(); router_phase(F, l, CW_CNT); } SEAM(pb + 3);
        if (IN(pb + 4)) {
            REFRESH(); moe_tables(F, l);
            pg8::MoeOrder<true> S{(int)F.MISC[MW_TSTART + NE], F.G, F.bid, D, (const char*)(F.ws + WS_H8), (const char*)(F.ws + WS_W13) + (size_t)l * NE * 2048 * D, (size_t)2048 * D,
                (const int*)(F.ws + WS_LIST), (const LAS int*)(F.MISC + MW_TILE), (const LAS int*)(F.MISC + MW_TSTART), (const LAS int*)(F.MISC + MW_CNT)};
            pg8::EpiSwiglu E{HID};
            for (int rep = 0; rep <= DUP(5); ++rep) { if (rep) xcd_barrier(bar); pg8::gemm_phase<pg8::EpiSwiglu, pg8::MoeOrder<true>, true>(F.lds, D, S, E, F.wave); }
        } SEAM(pb + 4);
        if (IN(pb + 5)) {
            REFRESH(); moe_tables(F, l);
            pg8::MoeOrder<false> S{(int)F.MISC[MW_TSTART + NE], F.G, F.bid, DE, (const char*)HID, (const char*)(F.ws + WS_W2) + (size_t)l * NE * D * DE, (size_t)D * DE,
                nullptr, (const LAS int*)(F.MISC + MW_TILE), (const LAS int*)(F.MISC + MW_TSTART), (const LAS int*)(F.MISC + MW_CNT)};
            pg8::EpiFp8 E{YBb, D};
            for (int rep = 0; rep <= DUP(6); ++rep) { if (rep) xcd_barrier(bar); pg8::gemm_phase<pg8::EpiFp8, pg8::MoeOrder<false>, true>(F.lds, DE, S, E, F.wave); }
        } SEAM(pb + 5);
        if (IN(pb + 6)) { REFRESH(); moe_tables(F, l); for (int rep = 0; rep <= (DUP(7) && l == NLAYER - 1 ? 1 : 0); ++rep) { if (rep) xcd_barrier(bar); combine_phase(F, l); } } SEAM(pb + 6);
    }
#undef IN
#undef SEAM
}

extern "C" void kernel_launch(void* const* d_in, const int* in_sizes, int n_in, void* d_out, int out_size, void* d_ws, size_t ws_size, hipStream_t stream) {
    static int grid = 0;
    if (grid == 0) {
        if (n_in != 14 || in_sizes[0] != T * D || out_size != T * D || ws_size < WS_END) { fprintf(stderr, "kernel_launch: unexpected shapes (n_in %d, in0 %d, out %d, ws %zu < %zu); nothing launched\n", n_in, n_in > 0 ? in_sizes[0] : -1, out_size, ws_size, (size_t)WS_END); grid = -1; return; }
        int dev = 0, cus = 0, per_cu = 0;
        if (hipGetDevice(&dev) != hipSuccess || hipDeviceGetAttribute(&cus, hipDeviceAttributeMultiprocessorCount, dev) != hipSuccess) { grid = -1; return; }
        if (hipFuncSetAttribute((const void*)mk_fwd, hipFuncAttributeMaxDynamicSharedMemorySize, LDS_BYTES) != hipSuccess) { fprintf(stderr, "kernel_launch: hipFuncSetAttribute failed\n"); grid = -1; return; }
        if (hipOccupancyMaxActiveBlocksPerMultiprocessor(&per_cu, (const void*)mk_fwd, NWAVES * 64, LDS_BYTES) != hipSuccess || per_cu < 1)
            fprintf(stderr, "kernel_launch: note: occupancy query reports %d workgroups per CU\n", per_cu);
        (void)hipGetLastError();
        grid = cus;
    }
    if (grid < 0) return;
    if (hipMemsetAsync((char*)d_ws + WS_CTL, 0, CTL_ZERO_BYTES, stream) != hipSuccess) { fprintf(stderr, "kernel_launch: memset failed\n"); return; }
    Args a{};
    for (int i = 0; i < 14; ++i) a.in[i] = (const float*)d_in[i];
    a.out = (float*)d_out; a.ws = (unsigned char*)d_ws;
#if MK_PER_PHASE
    for (int p = 0; p < NPHASE; ++p) { a.ph_lo = p; a.ph_hi = p + 1; hipLaunchKernelGGL(mk_fwd, dim3(grid), dim3(NWAVES * 64), LDS_BYTES, stream, a); }
#else
    a.ph_lo = 0; a.ph_hi = NPHASE;
    hipLaunchKernelGGL(mk_fwd, dim3(grid), dim3(NWAVES * 64), LDS_BYTES, stream, a);
#endif
    const hipError_t le = hipPeekAtLastError();
    if (le != hipSuccess) fprintf(stderr, "kernel_launch: launch failed: %s\n", hipGetErrorName(le));
}
```

```cpp
#include <hip/hip_runtime.h>
#include <cstdio>
#include <cstdint>

#ifndef DUP_MASK
#define DUP_MASK 0
#endif
#ifndef MK_PER_PHASE
#define MK_PER_PHASE 0
#ifndef NCV_SET
#define NCV_SET 40
#endif
#ifndef P2_CHUNKS
#define P2_CHUNKS 3
#endif
#endif

constexpr int T = 32768, D = 2048, NZ = 7168, SEQ = 2048, NHEAD = 8, HD = 128, CHUNK = 64;
constexpr int NE = 32, DE = 1024, NLAYER = 2;
constexpr int MAXROWS = 65536 + NE * 256;
constexpr int MAXTILES = MAXROWS / 256;
constexpr float EPS = 1e-6f;
constexpr int NPHASE = 1 + 7 * NLAYER;

constexpr size_t MiB = 1u << 20;
constexpr size_t WS_CTL = 0, CTL_ZERO_BYTES = 64 * 1024;
constexpr size_t WS_ROPE = 1 * MiB;
constexpr size_t WS_WR = 2 * MiB;
constexpr size_t WS_INFO = 3 * MiB;
constexpr size_t WS_LIST = 4 * MiB;
constexpr size_t WS_WIN = 8 * MiB;
constexpr size_t WS_WOUT = 64 * MiB;
constexpr size_t WS_W13 = 80 * MiB;
constexpr size_t WS_W2 = 336 * MiB;
constexpr size_t WS_H8 = 464 * MiB;
constexpr size_t WS_WIN8 = 528 * MiB;
constexpr size_t WS_H = 848 * MiB;
constexpr size_t WS_Z = 976 * MiB;
constexpr size_t WS_HID = WS_Z;
constexpr size_t WS_YB = WS_Z + 144 * MiB;
constexpr size_t WS_Y = 1424 * MiB;
constexpr size_t WS_X1 = 1552 * MiB;
constexpr size_t WS_END = 1808 * MiB;
static_assert((size_t)MAXROWS * 1024 * 2 <= 144 * MiB && (size_t)MAXROWS * 2048 * 2 <= 288 * MiB && 144 + 288 <= 448, "overlay");
constexpr int CW_BAR = 0, CW_CNT = 4096, CW_Q = 4352, CW_Q2 = 4416;

constexpr int MISC_OFF = 143360;
constexpr int LDS_BYTES = 147456;
constexpr int MW_BAR = 0, MW_TSTART = 16, MW_CNT = 64, MW_TILE = 128;
static_assert(MISC_OFF + (MW_TILE + 320) * 4 <= LDS_BYTES, "LDS map");

#define GAS __attribute__((address_space(1)))
#define LAS __attribute__((address_space(3)))
typedef unsigned short bf16;
typedef unsigned v4u __attribute__((ext_vector_type(4)));
typedef unsigned v2u __attribute__((ext_vector_type(2)));
typedef float f32x4 __attribute__((ext_vector_type(4)));
typedef float f32x2 __attribute__((ext_vector_type(2)));
typedef float f32x16 __attribute__((ext_vector_type(16)));
typedef short bf16x8 __attribute__((ext_vector_type(8)));
typedef int i32x4 __attribute__((ext_vector_type(4)));
#define LDS_WAIT() asm volatile("s_waitcnt lgkmcnt(0)" ::: "memory")
#define VM_WAIT() asm volatile("s_waitcnt vmcnt(0)" ::: "memory")
typedef __bf16 bf16v2 __attribute__((ext_vector_type(2)));
__device__ __forceinline__ unsigned pk2(float lo, float hi) { const bf16v2 v = __builtin_convertvector((f32x2){lo, hi}, bf16v2); return __builtin_bit_cast(unsigned, v); }
__device__ __forceinline__ unsigned f2bf(float f) { return pk2(f, 0.f) & 0xffffu; }
__device__ __forceinline__ float bflo(unsigned w) { return __builtin_bit_cast(float, w << 16); }
__device__ __forceinline__ float bfhi(unsigned w) { return __builtin_bit_cast(float, w & 0xffff0000u); }
__device__ __forceinline__ float bf2f(bf16 b) { return __builtin_bit_cast(float, ((unsigned)b) << 16); }
__device__ __forceinline__ float shx(float v, int o, int lane) { return __builtin_bit_cast(float, __builtin_amdgcn_ds_bpermute((lane ^ o) << 2, __builtin_bit_cast(int, v))); }
__device__ __forceinline__ float wave_sum(float v, int lane) {
#pragma unroll
    for (int o = 1; o < 64; o <<= 1) v += shx(v, o, lane);
    return v;
}

#define XB_TMO      128
#define XB_XCNT(j)  (256  + 64 * (j))
#define XB_XSUB(j)  (1280 + 64 * (j))
#define XB_XGEN(j)  (2304 + 64 * (j))
#define XB_TOP      3328
#define XB_TOPGEN   3392
#define XCD_BAR_WORDS 3456
#define XB_SPIN_CAP (1u << 20)
__device__ __forceinline__ unsigned xb_ld(unsigned* p)              { return __hip_atomic_load(p, __ATOMIC_RELAXED, __HIP_MEMORY_SCOPE_AGENT); }
__device__ __forceinline__ unsigned xb_add(unsigned* p, unsigned v) { return __hip_atomic_fetch_add(p, v, __ATOMIC_RELAXED, __HIP_MEMORY_SCOPE_AGENT); }
__device__ __forceinline__ unsigned xb_xcc_id() { return (unsigned)__builtin_amdgcn_s_getreg((3 << 11) | 20) & 0xFu; }
#define XB_SPIN(cond, bar) do { unsigned _sp = 0; while (cond) { __builtin_amdgcn_s_sleep(1); \
    if ((++_sp & 255u) == 0u) { if (xb_ld(&(bar)[XB_TMO])) break; if (_sp > XB_SPIN_CAP) { atomicAdd(&(bar)[XB_TMO], 1u); break; } } } } while (0)
struct XcdBarrier { unsigned* bar; unsigned x; volatile LAS unsigned* st; };
__device__ __forceinline__ XcdBarrier xcd_barrier_post(unsigned* bar, volatile LAS unsigned* st) {
    XcdBarrier b; b.bar = bar; b.x = xb_xcc_id(); b.st = st;
    if (threadIdx.x == 0) (void)xb_add(&bar[XB_XCNT(b.x)], 1u);
    return b;
}
__device__ __forceinline__ void xcd_barrier_complete(unsigned* bar, unsigned x, unsigned& nloc, unsigned& nx) {
    const unsigned G = gridDim.x * gridDim.y * gridDim.z;
    unsigned sum, cnt, mine, sp = 0u;
    for (;;) {
        sum = 0u; cnt = 0u; mine = 0u;
#pragma unroll
        for (unsigned j = 0; j < 16; ++j) { const unsigned c = xb_ld(&bar[XB_XCNT(j)]); sum += c; cnt += (c > 0u) ? 1u : 0u; mine = (j == x) ? c : mine; }
        if (sum == G) break;
        __builtin_amdgcn_s_sleep(1);
        if ((++sp & 255u) == 0u) { if (xb_ld(&bar[XB_TMO])) break; if (sp > XB_SPIN_CAP) { atomicAdd(&bar[XB_TMO], 1u); break; } }
    }
    nloc = mine > 0u ? mine : 1u; nx = cnt > 0u ? cnt : 1u;
}
__device__ __forceinline__ void xcd_barrier(const XcdBarrier& b) {
    asm volatile("s_waitcnt vmcnt(0)" ::: "memory");
    __syncthreads();
    if (threadIdx.x == 0) {
        unsigned* bar = b.bar; unsigned bx = b.x;
        asm volatile("" : "+s"(bar), "+s"(bx));
        __builtin_amdgcn_s_waitcnt(0);
        unsigned nloc = b.st[0], nx = b.st[1];
        if (nloc == 0u) { xcd_barrier_complete(bar, bx, nloc, nx); b.st[0] = nloc; b.st[1] = nx; }
        const unsigned old = xb_add(&bar[XB_XSUB(bx)], 1u);
        const unsigned gen = old / nloc;
        if (old + 1u == (gen + 1u) * nloc) {
            __builtin_amdgcn_fence(__ATOMIC_RELEASE, "agent");
            asm volatile("s_waitcnt vmcnt(0)" ::: "memory");
            const unsigned og = xb_add(&bar[XB_TOP], 1u);
            const unsigned tg = og / nx;
            if (og + 1u == (tg + 1u) * nx) xb_add(&bar[XB_TOPGEN], 1u);
            else XB_SPIN(xb_ld(&bar[XB_TOPGEN]) == tg, bar);
            __builtin_amdgcn_fence(__ATOMIC_ACQUIRE, "agent");
            xb_add(&bar[XB_XGEN(bx)], 1u);
            asm volatile("s_waitcnt vmcnt(0)" ::: "memory");
        } else {
            XB_SPIN(xb_ld(&bar[XB_XGEN(bx)]) == gen, bar);
            __builtin_amdgcn_fence(__ATOMIC_ACQUIRE, "agent");
            asm volatile("s_waitcnt vmcnt(0)" ::: "memory");
        }
    }
    __syncthreads();
}

namespace pg8 {
#define PG8_LAS __attribute__((address_space(3)))
typedef unsigned short bf16_t;
typedef unsigned u32x4 __attribute__((ext_vector_type(4)));
constexpr int BM = 256, BK = 64, HALF = 128, HTB = HALF * BK * 2, STAGE_BYTES = 8 * HTB, NXCD = 8, WGM = 8;
__host__ __device__ __forceinline__ int lds_byte(int r, int c) { const int st = (r >> 4) * 2 + (c >> 5), rr = r & 15, cc = c & 31, ob = rr * 64 + cc * 2; return st * 1024 + (ob ^ (((ob >> 9) & 1) << 5)); }
__host__ __device__ __forceinline__ void stage_rc(int b, int& R, int& C) { const int st = b / 1024, sb = b % 1024, swz = sb ^ (((sb >> 9) & 1) << 5); R = (st >> 1) * 16 + swz / 64; C = (st & 1) * 32 + (swz % 64) / 2; }
__host__ __device__ __forceinline__ int perm32(int rho) { const int n = rho >> 4, i = rho & 15; return 8 * (i >> 2) + 4 * n + (i & 3); }

struct Unit { int pm, pn, e; };
typedef int i32x8 __attribute__((ext_vector_type(8)));
typedef int i32x4v __attribute__((ext_vector_type(4)));
struct Frag { i32x8 v; };
__device__ __forceinline__ Frag ldfrag2(const PG8_LAS unsigned char* p) { Frag f; f.v = __builtin_shufflevector(*(const PG8_LAS i32x4v*)p, *(const PG8_LAS i32x4v*)(p + 1024), 0, 1, 2, 3, 4, 5, 6, 7); return f; }
__device__ __forceinline__ bf16x8 fhalf(const Frag& f, int k) { const i32x4v h = k ? __builtin_shufflevector(f.v, f.v, 4, 5, 6, 7) : __builtin_shufflevector(f.v, f.v, 0, 1, 2, 3); return __builtin_bit_cast(bf16x8, h); }
__device__ __forceinline__ unsigned cvt_pk_bf16(float lo, float hi) { unsigned r; asm volatile("v_cvt_pk_bf16_f32 %0, %1, %2" : "=v"(r) : "v"(lo), "v"(hi)); return r; }

__device__ __forceinline__ bool order_next(int nM, int nN, int G, int c, int i, int& pm, int& pn) {
    const int nwg = nM * nN; const long L = (long)i * G + c; if (L >= nwg) return false;
    int wgid = (int)L; { const int q = nwg / NXCD, r = nwg % NXCD, xcd = wgid % NXCD, off = wgid / NXCD; wgid = (xcd < r ? xcd * (q + 1) : r * (q + 1) + (xcd - r) * q) + off; }
    const int nig = WGM * nN, gid = wgid / nig, fm = gid * WGM, gsz = (nM - fm) < WGM ? (nM - fm) : WGM;
    pm = fm + ((wgid % nig) % gsz); pn = (wgid % nig) / gsz; return true;
}
struct DenseOrder {
    int nM, nN, G, c, KB; const char* A; const char* Bt;
    __device__ __forceinline__ bool next(int i, Unit& u) const { u.e = 0; return order_next(nM, nN, G, c, i, u.pm, u.pn); }
    __device__ __forceinline__ const char* a_base(const Unit& u) const { return A + (size_t)u.pm * (size_t)BM * KB; }
    __device__ __forceinline__ const char* b_base(const Unit& u) const { return Bt + (size_t)u.pn * (size_t)BM * KB; }
    __device__ __forceinline__ void a_offs(const Unit&, const int (&R)[2], const int (&Cb)[2], unsigned (&vo)[2][2]) const {
#pragma unroll
        for (int h = 0; h < 2; ++h)
#pragma unroll
            for (int i = 0; i < 2; ++i) vo[h][i] = (unsigned)((h * HALF + R[i]) * KB + Cb[i]);
    }
    __device__ __forceinline__ void a_idx(const Unit&, const int (&R)[2], int (&tok)[2][2]) const {
#pragma unroll
        for (int h = 0; h < 2; ++h)
#pragma unroll
            for (int i = 0; i < 2; ++i) tok[h][i] = h * HALF + R[i]; }
    __device__ __forceinline__ void a_vo(const int (&tok)[2][2], const int (&Cb)[2], unsigned (&vo)[2][2]) const {
#pragma unroll
        for (int h = 0; h < 2; ++h)
#pragma unroll
            for (int i = 0; i < 2; ++i) vo[h][i] = (unsigned)tok[h][i] * (unsigned)KB + (unsigned)Cb[i]; }
};
template <bool GATHER> struct MoeOrder {
    int nT, G, c, KB; const char* A; const char* Bt; size_t bexp;
    const int* list; const LAS int* tile_e; const LAS int* tstart; const LAS int* cnt;
    __device__ __forceinline__ bool next(int i, Unit& u) const { if (!order_next(nT, 8, G, c, i, u.pm, u.pn)) return false; u.e = tile_e[u.pm]; return true; }
    __device__ __forceinline__ const char* a_base(const Unit& u) const { return GATHER ? A : A + (size_t)u.pm * (size_t)BM * KB; }
    __device__ __forceinline__ const char* b_base(const Unit& u) const { return Bt + (size_t)u.e * bexp + (size_t)u.pn * (size_t)BM * KB; }
    __device__ __forceinline__ void a_offs(const Unit& u, const int (&R)[2], const int (&Cb)[2], unsigned (&vo)[2][2]) const {
        if (GATHER) {
            const int base = (u.pm - tstart[u.e]) * BM, n = cnt[u.e]; const int* le = list + (size_t)u.e * T;
            int tok[2][2];
#pragma unroll
            for (int h = 0; h < 2; ++h)
#pragma unroll
                for (int i = 0; i < 2; ++i) { const int s = base + h * HALF + R[i]; tok[h][i] = le[s < n ? s : 0]; }
#pragma unroll
            for (int h = 0; h < 2; ++h)
#pragma unroll
                for (int i = 0; i < 2; ++i) vo[h][i] = (unsigned)tok[h][i] * (unsigned)KB + (unsigned)Cb[i];
        } else {
#pragma unroll
            for (int h = 0; h < 2; ++h)
#pragma unroll
                for (int i = 0; i < 2; ++i) vo[h][i] = (unsigned)((h * HALF + R[i]) * KB + Cb[i]);
        }
    }
    __device__ __forceinline__ void a_idx(const Unit& u, const int (&R)[2], int (&tok)[2][2]) const {
        if (GATHER) { const int base = (u.pm - tstart[u.e]) * BM, n = cnt[u.e]; const int* le = list + (size_t)u.e * T;
#pragma unroll
            for (int h = 0; h < 2; ++h)
#pragma unroll
                for (int i = 0; i < 2; ++i) { const int s = base + h * HALF + R[i]; tok[h][i] = le[s < n ? s : 0]; } }
        else {
#pragma unroll
            for (int h = 0; h < 2; ++h)
#pragma unroll
                for (int i = 0; i < 2; ++i) tok[h][i] = h * HALF + R[i]; } }
    __device__ __forceinline__ void a_vo(const int (&tok)[2][2], const int (&Cb)[2], unsigned (&vo)[2][2]) const {
#pragma unroll
        for (int h = 0; h < 2; ++h)
#pragma unroll
            for (int i = 0; i < 2; ++i) vo[h][i] = (unsigned)tok[h][i] * (unsigned)KB + (unsigned)Cb[i]; }
};

struct EpiBf16 {
    static constexpr bool PERM = true; static constexpr int BMAP = 2;
    bf16_t* O; int ldc; int coff;
    __device__ __forceinline__ void operator()(const f32x4 (&acc)[2][2][4][2], const Unit& u, int wr, int wc, int fr, int fq) const {
        const int odd = fr & 1;
        bf16_t* base = O + (size_t)(u.pm * BM + wr * 64) * ldc + coff + u.pn * BM + wc * 64 + (odd ? 32 : 0) + 8 * fq;
#pragma unroll
        for (int ai = 0; ai < 2; ++ai)
#pragma unroll
            for (int m = 0; m < 4; ++m) { u32x4 w[2];
#pragma unroll
                for (int bj = 0; bj < 2; ++bj) { const f32x4 v0 = acc[ai][bj][m][0], v1 = acc[ai][bj][m][1];
                    w[bj].x = cvt_pk_bf16(v0[0], v0[1]); w[bj].y = cvt_pk_bf16(v0[2], v0[3]); w[bj].z = cvt_pk_bf16(v1[0], v1[1]); w[bj].w = cvt_pk_bf16(v1[2], v1[3]); }
                const u32x4 x = odd ? w[0] : w[1]; u32x4 y;
                y.x = (unsigned)__builtin_amdgcn_mov_dpp((int)x.x, 0xB1, 0xF, 0xF, true); y.y = (unsigned)__builtin_amdgcn_mov_dpp((int)x.y, 0xB1, 0xF, 0xF, true);
                y.z = (unsigned)__builtin_amdgcn_mov_dpp((int)x.z, 0xB1, 0xF, 0xF, true); y.w = (unsigned)__builtin_amdgcn_mov_dpp((int)x.w, 0xB1, 0xF, 0xF, true);
                bf16_t* r0p = base + (size_t)(ai * HALF + m * 16 + (fr & ~1)) * ldc;
                *(u32x4*)r0p = odd ? y : w[0];
                *(u32x4*)(r0p + ldc) = odd ? w[1] : y; }
    }
};
struct EpiFp8 {
    static constexpr bool PERM = true; static constexpr int BMAP = 1;
    unsigned char* O; int ldc;
    __device__ __forceinline__ void operator()(const f32x4 (&acc)[2][2][4][2], const Unit& u, int wr, int wc, int fr, int fq) const {
        const int row0 = u.pm * BM + wr * 64 + fr, col0 = u.pn * BM + wc * 64 + 16 * fq;
#pragma unroll
        for (int ai = 0; ai < 2; ++ai)
#pragma unroll
            for (int m = 0; m < 4; ++m) { unsigned char* rowp = O + (size_t)(row0 + ai * HALF + m * 16) * ldc + col0; int w[4];
#pragma unroll
                for (int bj = 0; bj < 2; ++bj)
#pragma unroll
                    for (int n = 0; n < 2; ++n) { const f32x4 v = acc[ai][bj][m][n]; int t = 0; t = __builtin_amdgcn_cvt_pk_fp8_f32(v[0], v[1], t, false); t = __builtin_amdgcn_cvt_pk_fp8_f32(v[2], v[3], t, true); w[2 * bj + n] = t; }
                *(i32x4v*)rowp = (i32x4v){w[0], w[1], w[2], w[3]}; }
    }
};
struct EpiConvIn {
    static constexpr bool PERM = true; static constexpr int BMAP = 2;
    bf16_t* O; int ldc;
    __device__ __forceinline__ void operator()(const f32x4 (&acc)[2][2][4][2], const Unit& u, int wr, int wc, int fr, int fq) const {
        const int row0 = u.pm * BM + wr * 64 + fr;
        if (u.pn < 4) { const int odd = fr & 1;
            bf16_t* base = O + (size_t)(u.pm * BM + wr * 64) * ldc + u.pn * BM + wc * 64 + (odd ? 32 : 0) + 8 * fq;
#pragma unroll
            for (int ai = 0; ai < 2; ++ai)
#pragma unroll
                for (int m = 0; m < 4; ++m) { u32x4 w[2];
#pragma unroll
                    for (int bj = 0; bj < 2; ++bj) { const f32x4 v0 = acc[ai][bj][m][0], v1 = acc[ai][bj][m][1];
                        w[bj].x = cvt_pk_bf16(v0[0], v0[1]); w[bj].y = cvt_pk_bf16(v0[2], v0[3]); w[bj].z = cvt_pk_bf16(v1[0], v1[1]); w[bj].w = cvt_pk_bf16(v1[2], v1[3]); }
                    const u32x4 x = odd ? w[0] : w[1]; u32x4 y;
                    y.x = (unsigned)__builtin_amdgcn_mov_dpp((int)x.x, 0xB1, 0xF, 0xF, true); y.y = (unsigned)__builtin_amdgcn_mov_dpp((int)x.y, 0xB1, 0xF, 0xF, true);
                    y.z = (unsigned)__builtin_amdgcn_mov_dpp((int)x.z, 0xB1, 0xF, 0xF, true); y.w = (unsigned)__builtin_amdgcn_mov_dpp((int)x.w, 0xB1, 0xF, 0xF, true);
                    bf16_t* r0p = base + (size_t)(ai * HALF + m * 16 + (fr & ~1)) * ldc;
                    *(u32x4*)r0p = odd ? y : w[0];
                    *(u32x4*)(r0p + ldc) = odd ? w[1] : y; } }
        else { const int col0 = 1024 + (u.pn - 4) * HALF + wc * 32 + 8 * fq;
#pragma unroll
            for (int ai = 0; ai < 2; ++ai)
#pragma unroll
                for (int m = 0; m < 4; ++m) { const f32x4 c0 = acc[ai][0][m][0], c1 = acc[ai][0][m][1], v0 = acc[ai][1][m][0], v1 = acc[ai][1][m][1];
                    u32x4 w; w.x = cvt_pk_bf16(c0[0] * v0[0], c0[1] * v0[1]); w.y = cvt_pk_bf16(c0[2] * v0[2], c0[3] * v0[3]); w.z = cvt_pk_bf16(c1[0] * v1[0], c1[1] * v1[1]); w.w = cvt_pk_bf16(c1[2] * v1[2], c1[3] * v1[3]);
                    *(u32x4*)(O + (size_t)(row0 + ai * HALF + m * 16) * ldc + col0) = w; } }
    }
};
struct EpiResid {
    static constexpr bool PERM = true; static constexpr int BMAP = 2;
    bf16_t* X; int ldc;
    __device__ __forceinline__ void operator()(const f32x4 (&acc)[2][2][4][2], const Unit& u, int wr, int wc, int fr, int fq) const {
        const int odd = fr & 1;
        bf16_t* seg = X + (size_t)(u.pm * BM + wr * 64) * ldc + u.pn * BM + wc * 64 + 8 * fq;
        u32x4 rs[2][4][2];
#pragma unroll
        for (int ai = 0; ai < 2; ++ai)
#pragma unroll
            for (int m = 0; m < 4; ++m) { const bf16_t* rowp = seg + (size_t)(ai * HALF + m * 16 + fr) * ldc;
#pragma unroll
                for (int bj = 0; bj < 2; ++bj) rs[ai][m][bj] = *(const u32x4*)(rowp + 32 * bj); }
#pragma unroll
        for (int ai = 0; ai < 2; ++ai)
#pragma unroll
            for (int m = 0; m < 4; ++m) { u32x4 w[2];
#pragma unroll
                for (int bj = 0; bj < 2; ++bj) { const u32x4 bs = rs[ai][m][bj]; const f32x4 v0 = acc[ai][bj][m][0], v1 = acc[ai][bj][m][1];
                    w[bj].x = cvt_pk_bf16(v0[0] + __builtin_bit_cast(float, bs.x << 16), v0[1] + __builtin_bit_cast(float, bs.x & 0xffff0000u)); w[bj].y = cvt_pk_bf16(v0[2] + __builtin_bit_cast(float, bs.y << 16), v0[3] + __builtin_bit_cast(float, bs.y & 0xffff0000u));
                    w[bj].z = cvt_pk_bf16(v1[0] + __builtin_bit_cast(float, bs.z << 16), v1[1] + __builtin_bit_cast(float, bs.z & 0xffff0000u)); w[bj].w = cvt_pk_bf16(v1[2] + __builtin_bit_cast(float, bs.w << 16), v1[3] + __builtin_bit_cast(float, bs.w & 0xffff0000u)); }
                const u32x4 x = odd ? w[0] : w[1]; u32x4 y;
                y.x = (unsigned)__builtin_amdgcn_mov_dpp((int)x.x, 0xB1, 0xF, 0xF, true); y.y = (unsigned)__builtin_amdgcn_mov_dpp((int)x.y, 0xB1, 0xF, 0xF, true);
                y.z = (unsigned)__builtin_amdgcn_mov_dpp((int)x.z, 0xB1, 0xF, 0xF, true); y.w = (unsigned)__builtin_amdgcn_mov_dpp((int)x.w, 0xB1, 0xF, 0xF, true);
                bf16_t* r0p = seg + (odd ? 32 : 0) + (size_t)(ai * HALF + m * 16 + (fr & ~1)) * ldc;
                *(u32x4*)r0p = odd ? y : w[0];
                *(u32x4*)(r0p + ldc) = odd ? w[1] : y; }
    }
};
struct EpiSwiglu {
    static constexpr bool PERM = true; static constexpr int BMAP = 0;
    unsigned char* O;
    __device__ __forceinline__ void operator()(const f32x4 (&acc)[2][2][4][2], const Unit& u, int wr, int wc, int fr, int fq) const {
        const int row0 = u.pm * BM + wr * 64 + fr, col0 = u.pn * HALF + wc * 32 + 8 * fq;
#pragma unroll
        for (int ai = 0; ai < 2; ++ai)
#pragma unroll
            for (int m = 0; m < 4; ++m) { unsigned char* rowp = O + (size_t)(row0 + ai * HALF + m * 16) * 1024 + col0; float r[8];
#pragma unroll
                for (int n = 0; n < 2; ++n)
#pragma unroll
                    for (int j = 0; j < 4; ++j) { const float g = acc[ai][0][m][n][j], up = acc[ai][1][m][n][j]; r[4 * n + j] = g * up * __builtin_amdgcn_rcpf(1.0f + __expf(-g)); }
                int w0 = 0, w1 = 0; w0 = __builtin_amdgcn_cvt_pk_fp8_f32(r[0], r[1], w0, false); w0 = __builtin_amdgcn_cvt_pk_fp8_f32(r[2], r[3], w0, true);
                w1 = __builtin_amdgcn_cvt_pk_fp8_f32(r[4], r[5], w1, false); w1 = __builtin_amdgcn_cvt_pk_fp8_f32(r[6], r[7], w1, true);
                typedef int i32x2 __attribute__((ext_vector_type(2))); *(i32x2*)rowp = (i32x2){w0, w1}; }
    }
};

template <class Epi, class Sched, bool FP8 = false>
__device__ __forceinline__ void gemm_phase(PG8_LAS unsigned char* lds, const int KB, const Sched& S, const Epi& E, const int wave_id) {
    unsigned m_ = ~0u; asm volatile("" : "+s"(m_)); const int lane_ = (int)__builtin_amdgcn_mbcnt_hi(m_, __builtin_amdgcn_mbcnt_lo(m_, 0u));
    int wid_ = wave_id; asm volatile("" : "+s"(wid_));
    const int wid = wid_, lane = lane_, tid = wid * 64 + lane, wr = wid >> 2, wc = wid & 3, fr = lane & 15, fq = lane >> 4;
    const int nt = KB / (BK * 2);
    unsigned voffB[2]; int Rr[2], Cb[2];
#pragma unroll
    for (int i = 0; i < 2; ++i) { int R, C; stage_rc(tid * 16 + i * 8192, R, C); const int Rb = Epi::BMAP == 1 ? (64 * (R >> 5) + 16 * ((R >> 2) & 3) + 4 * ((R >> 4) & 1) + (R & 3)) : Epi::BMAP == 2 ? (64 * (R >> 5) + 8 * ((R >> 2) & 3) + 4 * ((R >> 4) & 1) + (R & 3)) : (Epi::PERM ? ((R & ~31) + perm32(R & 31)) : R);
        Rr[i] = R; Cb[i] = C * 2; voffB[i] = (unsigned)(Rb * KB + C * 2); }
    const size_t kstep = (size_t)(BK * 2);
    const size_t hstep = Epi::BMAP == 1 ? (size_t)8 * KB : Epi::BMAP == 2 ? (size_t)32 * KB : (size_t)HALF * KB;
    const unsigned ldsw = (unsigned)wid * 1024u;
    const int aoff = lds_byte(wr * 64 + fr, fq * 8), boff = lds_byte(wc * 32 + fr, fq * 8);
#define PG8_SA(b, h) (((b) * 2 + (h)) * HTB)
#define PG8_SB(b, h) ((4 + (b) * 2 + (h)) * HTB)
#define PG8_STAGE(bufoff, gbase, voff) do { _Pragma("unroll") for (int _i = 0; _i < 2; ++_i) \
        __builtin_amdgcn_global_load_lds((const unsigned*)((const char*)(gbase) + (voff)[_i]), (PG8_LAS unsigned*)(lds + (bufoff) + ldsw + _i * 8192), 16, 0, 0); } while (0)
#define PG8_LDA(dst, b, h) do { _Pragma("unroll") for (int m = 0; m < 4; ++m) dst[m] = ldfrag2(lds + PG8_SA(b, h) + aoff + m * 2048); } while (0)
#define PG8_LDB(dst, b, h) do { _Pragma("unroll") for (int n = 0; n < 2; ++n) dst[n] = ldfrag2(lds + PG8_SB(b, h) + boff + n * 2048); } while (0)
#define PG8_MMA(ai, bj, At, Bt) do { __builtin_amdgcn_s_setprio(1); _Pragma("unroll") for (int m = 0; m < 4; ++m) _Pragma("unroll") for (int n = 0; n < 2; ++n) { \
        if constexpr (FP8) { asm volatile("v_mfma_scale_f32_16x16x128_f8f6f4 %0, %1, %2, %0, %3, %4 op_sel_hi:[0,0,0]" : "+v"(acc[ai][bj][m][n]) : "v"(Bt[n].v), "v"(At[m].v), "v"(sc_w), "v"(sc_1)); } \
        else { _Pragma("unroll") for (int k = 0; k < 2; ++k) acc[ai][bj][m][n] = __builtin_amdgcn_mfma_f32_16x16x32_bf16(fhalf(Bt[n], k), fhalf(At[m], k), acc[ai][bj][m][n], 0, 0, 0); } } __builtin_amdgcn_s_setprio(0); } while (0)
#define PG8_WAIT_V(n) asm volatile("s_waitcnt vmcnt(" #n ")" ::: "memory")
#define PG8_WAIT_L(n) asm volatile("s_waitcnt lgkmcnt(" #n ")" ::: "memory")
#define PG8_BAR __builtin_amdgcn_s_barrier()
#define PG8_SCHED __builtin_amdgcn_sched_barrier(0)
    Unit cur, nxt; int ui = 0;
    if (!S.next(0, cur)) return;
    f32x4 acc[2][2][4][2];
#pragma unroll
    for (int a = 0; a < 2; ++a)
#pragma unroll
        for (int b = 0; b < 2; ++b)
#pragma unroll
            for (int m = 0; m < 4; ++m)
#pragma unroll
                for (int n = 0; n < 2; ++n) acc[a][b][m][n] = (f32x4){0.f, 0.f, 0.f, 0.f};
    Frag At[4], B0[2], B1[2];
    int sc_w = 0x79797979, sc_1 = 0x7f7f7f7f;
    if constexpr (FP8) asm volatile("" : "+v"(sc_w), "+v"(sc_1));
    unsigned voA[2][2], voN[2][2];
    S.a_offs(cur, Rr, Cb, voA);
    const char* cA = S.a_base(cur); const char* cB = S.b_base(cur);
    PG8_STAGE(PG8_SB(0, 0), cB, voffB); PG8_STAGE(PG8_SB(0, 1), cB + hstep, voffB); PG8_STAGE(PG8_SA(0, 0), cA, voA[0]); PG8_STAGE(PG8_SA(0, 1), cA, voA[1]);
    if (wr == 1) PG8_BAR;
    PG8_WAIT_V(2); PG8_BAR;
    PG8_STAGE(PG8_SB(1, 0), cB + kstep, voffB); PG8_STAGE(PG8_SA(1, 0), cA + kstep, voA[0]); PG8_STAGE(PG8_SB(1, 1), cB + hstep + kstep, voffB);
    PG8_WAIT_V(6); PG8_BAR;
    bool has_next = S.next(ui + 1, nxt);
    const char* nA = cA; const char* nB = cB;
    if (has_next) { S.a_offs(nxt, Rr, Cb, voN); nA = S.a_base(nxt); nB = S.b_base(nxt); }
    else {
#pragma unroll
        for (int h = 0; h < 2; ++h)
#pragma unroll
            for (int i = 0; i < 2; ++i) voN[h][i] = voA[h][i];
    }
    asm volatile("" : "+v"(voN[0][0]), "+v"(voN[0][1]), "+v"(voN[1][0]), "+v"(voN[1][1]));
    for (;;) {
#pragma nounroll
        for (int t = 0; t < nt; t += 2) {
            const bool last = (t == nt - 2);
            const char* a1 = cA + (size_t)(t + 1) * kstep;
            const char* a2 = last ? nA : cA + (size_t)(t + 2) * kstep; const char* b2 = last ? nB : cB + (size_t)(t + 2) * kstep;
            const char* a3 = a2 + kstep; const char* b3 = b2 + kstep;
            unsigned vo2[2][2];
#pragma unroll
            for (int h = 0; h < 2; ++h)
#pragma unroll
                for (int i = 0; i < 2; ++i) vo2[h][i] = last ? voN[h][i] : voA[h][i];
            PG8_LDB(B0, 0, 0); PG8_LDB(B1, 0, 1); PG8_SCHED; PG8_LDA(At, 0, 0); PG8_STAGE(PG8_SA(1, 1), a1, voA[1]);
            PG8_WAIT_V(8); PG8_WAIT_L(0); PG8_BAR; PG8_MMA(0, 0, At, B0); PG8_MMA(0, 1, At, B1); PG8_BAR; PG8_SCHED;
            PG8_LDA(At, 0, 1); PG8_STAGE(PG8_SB(0, 0), b2, voffB); PG8_STAGE(PG8_SB(0, 1), b2 + hstep, voffB); PG8_STAGE(PG8_SA(0, 0), a2, vo2[0]);
            PG8_WAIT_V(8); PG8_WAIT_L(0); PG8_BAR; PG8_MMA(1, 0, At, B0); PG8_MMA(1, 1, At, B1); PG8_BAR; PG8_SCHED;
            PG8_LDB(B0, 1, 0); PG8_LDB(B1, 1, 1); PG8_SCHED; PG8_LDA(At, 1, 0); PG8_STAGE(PG8_SA(0, 1), a2, vo2[1]);
            PG8_WAIT_V(8); PG8_WAIT_L(0); PG8_BAR; PG8_MMA(0, 0, At, B0); PG8_MMA(0, 1, At, B1); PG8_BAR; PG8_SCHED;
            PG8_LDA(At, 1, 1); PG8_STAGE(PG8_SB(1, 0), b3, voffB); PG8_STAGE(PG8_SB(1, 1), b3 + hstep, voffB); PG8_STAGE(PG8_SA(1, 0), a3, vo2[0]);
            PG8_WAIT_V(8); PG8_WAIT_L(0); PG8_BAR; PG8_MMA(1, 0, At, B0); PG8_MMA(1, 1, At, B1); PG8_BAR; PG8_SCHED;
        }
        if (wr == 0) PG8_BAR;
        if constexpr (FP8) asm volatile("s_nop 15\n\ts_nop 15" ::: "memory");
        Unit nn; nn.pm = 0; nn.pn = 0; nn.e = 0; bool has_nn = false; int tokn[2][2] = {{0, 0}, {0, 0}};
        if (has_next) { has_nn = S.next(ui + 2, nn); if (has_nn) S.a_idx(nn, Rr, tokn); }
        asm volatile("" ::: "memory");
        E(acc, cur, wr, wc, fr, fq);
        if (!has_next) break;
#pragma unroll
        for (int a = 0; a < 2; ++a)
#pragma unroll
            for (int b = 0; b < 2; ++b)
#pragma unroll
                for (int m = 0; m < 4; ++m)
#pragma unroll
                    for (int n = 0; n < 2; ++n) acc[a][b][m][n] = (f32x4){0.f, 0.f, 0.f, 0.f};
        if constexpr (FP8) asm volatile("s_nop 7" ::: "memory");
        cur = nxt; cA = nA; cB = nB; ++ui;
#pragma unroll
        for (int h = 0; h < 2; ++h)
#pragma unroll
            for (int i = 0; i < 2; ++i) voA[h][i] = voN[h][i];
        has_next = has_nn;
        if (has_nn) { nxt = nn; asm volatile("" : "+v"(tokn[0][0]), "+v"(tokn[0][1]), "+v"(tokn[1][0]), "+v"(tokn[1][1])); S.a_vo(tokn, Cb, voN); nA = S.a_base(nn); nB = S.b_base(nn); }
        else { nA = cA; nB = cB; }
        asm volatile("" : "+v"(voN[0][0]), "+v"(voN[0][1]), "+v"(voN[1][0]), "+v"(voN[1][1]));
        if (wr == 1) PG8_BAR;
    }
    PG8_WAIT_V(0);
    PG8_BAR;
#undef PG8_SA
#undef PG8_SB
#undef PG8_STAGE
#undef PG8_LDA
#undef PG8_LDB
#undef PG8_MMA
#undef PG8_WAIT_V
#undef PG8_WAIT_L
#undef PG8_BAR
#undef PG8_SCHED
}
}

struct Frame {
    LAS unsigned char* lds;
    volatile LAS unsigned* MISC;
    unsigned* ctl;
    int tid, lane, wave, G, bid;
    const float *x, *g_mix, *w_in, *conv_w, *w_out, *g_ffn, *w_group, *b_group, *w_router, *b_router, *w_gate, *w_up, *w_down, *g_final;
    float* out;
    unsigned char* ws;
};
constexpr int NWAVES = 8;

__device__ __forceinline__ void tr_item(const float* W, int ldw, int k0, int n0, bf16* WT, int ldd, int drow0, float scale, LAS float* scr, int lane) {
    float v[32];
#pragma unroll
    for (int i = 0; i < 32; ++i) v[i] = W[(size_t)(k0 + 2 * i + (lane >> 5)) * ldw + n0 + (lane & 31)];
#pragma unroll
    for (int i = 0; i < 32; ++i) scr[(2 * i + (lane >> 5)) * 33 + (lane & 31)] = v[i] * scale;
    LDS_WAIT(); asm volatile("" ::: "memory");
    const int c = lane & 7;
#pragma unroll
    for (int j = 0; j < 4; ++j) { const int n = (lane >> 3) + 8 * j; const LAS float* s = scr + (8 * c) * 33 + n;
        v4u o; o.x = pk2(s[0 * 33], s[1 * 33]); o.y = pk2(s[2 * 33], s[3 * 33]); o.z = pk2(s[4 * 33], s[5 * 33]); o.w = pk2(s[6 * 33], s[7 * 33]);
        *(v4u*)(WT + (size_t)(drow0 + n) * ldd + k0 + 8 * c) = o; }
    LDS_WAIT(); asm volatile("" ::: "memory");
}
__device__ __forceinline__ void tr_item8(const float* W, int ldw, int k0, int n0, unsigned char* WT, int ldd, int drow0, float scale, LAS float* scr, int lane) {
    float v[64];
#pragma unroll
    for (int i = 0; i < 64; ++i) v[i] = W[(size_t)(k0 + 2 * i + (lane >> 5)) * ldw + n0 + (lane & 31)];
#pragma unroll
    for (int i = 0; i < 64; ++i) scr[(2 * i + (lane >> 5)) * 33 + (lane & 31)] = v[i] * scale;
    LDS_WAIT(); asm volatile("" ::: "memory");
    const int c = lane & 7;
#pragma unroll
    for (int j = 0; j < 4; ++j) { const int n = (lane >> 3) + 8 * j; const LAS float* sp = scr + (16 * c) * 33 + n; int w[4];
#pragma unroll
        for (int q = 0; q < 4; ++q) { int t = 0; t = __builtin_amdgcn_cvt_pk_fp8_f32(sp[(4 * q + 0) * 33], sp[(4 * q + 1) * 33], t, false); t = __builtin_amdgcn_cvt_pk_fp8_f32(sp[(4 * q + 2) * 33], sp[(4 * q + 3) * 33], t, true); w[q] = t; }
        *(v4u*)(WT + (size_t)(drow0 + n) * ldd + k0 + 16 * c) = (v4u){(unsigned)w[0], (unsigned)w[1], (unsigned)w[2], (unsigned)w[3]}; }
    LDS_WAIT(); asm volatile("" ::: "memory");
}
__device__ __forceinline__ unsigned pk4_fp8(float a, float b, float c, float d) { int w = 0; w = __builtin_amdgcn_cvt_pk_fp8_f32(a, b, w, false); w = __builtin_amdgcn_cvt_pk_fp8_f32(c, d, w, true); return (unsigned)w; }
__device__ __forceinline__ void norm_row_bf16(const float* xrow, const float* g, bf16* orow, unsigned char* orow8, bf16* xcopy, int lane) {
    const f32x4* xr = (const f32x4*)xrow + lane; f32x4 v[8]; float s = 0.f; v2u* xc = (v2u*)xcopy + lane;
#pragma unroll
    for (int j = 0; j < 8; ++j) { v[j] = xr[64 * j]; s += (v[j].x * v[j].x + v[j].y * v[j].y) + (v[j].z * v[j].z + v[j].w * v[j].w); xc[64 * j] = (v2u){pk2(v[j].x, v[j].y), pk2(v[j].z, v[j].w)}; }
    const float rstd = 1.0f / sqrtf(wave_sum(s, lane) * (1.0f / D) + EPS);
    const f32x4* gr = (const f32x4*)g + lane; v2u* o8 = (v2u*)orow + lane; unsigned* of8 = (unsigned*)orow8 + lane;
#pragma unroll
    for (int j = 0; j < 8; ++j) { const f32x4 gv = gr[64 * j]; const f32x4 hv = v[j] * rstd * gv; v2u o; o.x = pk2(hv.x, hv.y); o.y = pk2(hv.z, hv.w); o8[64 * j] = o; of8[64 * j] = pk4_fp8(hv.x, hv.y, hv.z, hv.w); }
}
__device__ __forceinline__ void sincos_d(double a, float& c, float& s) {
    const double twopi = 6.283185307179586476925286766559, inv = 0.15915494309189533576888376337251;
    const double r = a - twopi * __builtin_rint(a * inv), r2 = r * r;
    double ss = 0.0, cc = 0.0;
#pragma unroll
    for (int k = 12; k >= 1; --k) { ss = (ss + 1.0) * (-r2 / (double)((2 * k) * (2 * k + 1))); cc = (cc + 1.0) * (-r2 / (double)((2 * k - 1) * (2 * k))); }
    s = (float)(r * (1.0 + ss)); c = (float)(1.0 + cc);
}
constexpr int I_IN = NLAYER * 32 * 96, I_IN8 = NLAYER * 16 * 128, I_OUT = NLAYER * 32 * 64, I_G = NLAYER * NE * 16 * 32, I_D = NLAYER * NE * 8 * 64;
constexpr int NITEMS = I_IN + I_IN8 + I_OUT + 2 * I_G + I_D;
__device__ __forceinline__ int cw_vit(int qsel, int v) {
    constexpr int hIN = I_IN / 2, hIN8 = I_IN8 / 2, hG = I_G / 2, hD = I_D / 2, oG = I_IN + I_IN8 + I_OUT, oU = oG + I_G, oD = oU + I_G;
    if (qsel == 2) return v < hG ? oG + hG + v : (v < 2 * hG ? oU + hG + (v - hG) : oD + hD + (v - 2 * hG));
    if (v < hIN) return hIN + v; v -= hIN;
    if (v < hIN8) return I_IN + hIN8 + v; v -= hIN8;
    if (v < I_OUT) return I_IN + I_IN8 + v; v -= I_OUT;
    if (v < hG) return oG + v; v -= hG;
    if (v < hG) return oU + v; v -= hG;
    return oD + v;
}
__device__ __forceinline__ void conv_weights(Frame& F, int it_lo, int it_hi, int cb, int ncb, unsigned* q = nullptr, const int qsel = 1, const int maxc = 0x7fffffff) {
    LAS float* scr = (LAS float*)(F.lds + F.wave * 17408);
    const int gw = cb * NWAVES + F.wave, NGW = ncb * NWAVES, lane = F.lane;
    bf16* WIN = (bf16*)(F.ws + WS_WIN); bf16* WOUT = (bf16*)(F.ws + WS_WOUT); unsigned char* W13 = F.ws + WS_W13; unsigned char* W2 = F.ws + WS_W2;
    struct CJ { const float* src; unsigned char* dst; int ldw, ldd, fp8; float scale; };
#define CW_DECODE(it_, J) do { int r = (it_); \
        if (r < I_IN) { const int l = r / (32 * 96), q = r % (32 * 96), kb = q / 96, nb = q % 96, n0 = nb * 32, k0 = kb * 64; \
            const int dr = n0 < 1024 ? n0 : (n0 < 2048 ? 1024 + 256 * ((n0 - 1024) >> 7) + 2 * (n0 & 96) + (n0 & 31) : 1024 + 256 * ((n0 - 2048) >> 7) + 2 * (n0 & 96) + 32 + (n0 & 31));     \
            J.src = F.w_in + (size_t)l * D * NZ + (size_t)k0 * NZ + n0; J.ldw = NZ; J.ldd = 2 * D; J.fp8 = 0; J.scale = 1.0f; J.dst = (unsigned char*)(WIN + (size_t)l * NZ * D + (size_t)dr * D + k0); } \
        else if ((r -= I_IN) < I_IN8) { const int l = r / (16 * 128), q = r % (16 * 128), kb = q / 128, nb = q % 128, n0 = 3072 + nb * 32, k0 = kb * 128; \
            J.src = F.w_in + (size_t)l * D * NZ + (size_t)k0 * NZ + n0; J.ldw = NZ; J.ldd = D; J.fp8 = 1; J.scale = 64.0f; J.dst = F.ws + WS_WIN8 + (size_t)l * 4096 * D + (size_t)(n0 - 3072) * D + k0; } \
        else if ((r -= I_IN8) < I_OUT) { const int l = r / (32 * 64), q = r % (32 * 64), kb = q / 64, nb = q % 64, n0 = nb * 32, k0 = kb * 64; \
            J.src = F.w_out + (size_t)l * D * D + (size_t)k0 * D + n0; J.ldw = D; J.ldd = 2 * D; J.fp8 = 0; J.scale = 1.0f; J.dst = (unsigned char*)(WOUT + (size_t)l * D * D + (size_t)n0 * D + k0); } \
        else if ((r -= I_OUT) < 2 * I_G) { const int up = r >= I_G; if (up) r -= I_G; const int le = r / 512, q = r % 512, kb = q / 32, nb = q % 32, n0 = nb * 32, k0 = kb * 128; \
            J.src = (up ? F.w_up : F.w_gate) + (size_t)le * D * DE + (size_t)k0 * DE + n0; J.ldw = DE; J.ldd = D; J.fp8 = 1; J.scale = 64.0f; \
            J.dst = W13 + (size_t)le * 2048 * D + (size_t)(256 * (n0 >> 7) + (up ? 128 : 0) + (n0 & 127)) * D + k0; } \
        else { r -= 2 * I_G; const int le = r / 512, q = r % 512, kb = q / 64, nb = q % 64, n0 = nb * 32, k0 = kb * 128; \
            J.src = F.w_down + (size_t)le * DE * D + (size_t)k0 * D + n0; J.ldw = D; J.ldd = DE; J.fp8 = 1; J.scale = 64.0f; J.dst = W2 + (size_t)le * D * DE + (size_t)n0 * DE + k0; } } while (0)
#define CW_LOAD(J, v) do { const f32x4* sp_ = (const f32x4*)(J.src + (size_t)(lane >> 3) * J.ldw) + (lane & 7); \
        _Pragma("unroll") for (int i = 0; i < 8; ++i) v[i] = __builtin_nontemporal_load((const f32x4*)((const float*)sp_ + (size_t)(8 * i) * J.ldw)); \
        if (J.fp8) { _Pragma("unroll") for (int i = 8; i < 16; ++i) v[i] = __builtin_nontemporal_load((const f32x4*)((const float*)sp_ + (size_t)(8 * i) * J.ldw)); } } while (0)
#define CW_ST(i_) do { const int k_ = 8 * (i_) + (lane >> 3); LAS float* wp_ = scr + k_ * 34 + ((4 * (lane & 7) + 4 * ((i_) >> 1)) & 31); const f32x4 t_ = v_[(i_)] * sc_; \
        *(LAS f32x2*)wp_ = (f32x2){t_.x, t_.y}; *(LAS f32x2*)(wp_ + 2) = (f32x2){t_.z, t_.w}; } while (0)
#define CW_PROC(J, v) do { const f32x4* v_ = v; const float sc_ = J.scale; \
        _Pragma("unroll") for (int i = 0; i < 8; ++i) CW_ST(i); \
        if (J.fp8) { _Pragma("unroll") for (int i = 8; i < 16; ++i) CW_ST(i); } \
        LDS_WAIT(); asm volatile("" ::: "memory"); \
        { const int c = lane & 7; \
          _Pragma("unroll") for (int j = 0; j < 4; ++j) { const int n = (lane >> 3) + 8 * j; \
            if (J.fp8) { const LAS float* sp = scr + (16 * c) * 34 + ((n + 4 * c) & 31); \
                __builtin_nontemporal_store((v4u){pk4_fp8(sp[0 * 34], sp[1 * 34], sp[2 * 34], sp[3 * 34]), pk4_fp8(sp[4 * 34], sp[5 * 34], sp[6 * 34], sp[7 * 34]), pk4_fp8(sp[8 * 34], sp[9 * 34], sp[10 * 34], sp[11 * 34]), pk4_fp8(sp[12 * 34], sp[13 * 34], sp[14 * 34], sp[15 * 34])}, (v4u*)(J.dst + (size_t)n * J.ldd + 16 * c)); } \
            else { const LAS float* sp = scr + (8 * c) * 34 + ((n + 4 * (c >> 1)) & 31); \
                __builtin_nontemporal_store((v4u){pk2(sp[0 * 34], sp[1 * 34]), pk2(sp[2 * 34], sp[3 * 34]), pk2(sp[4 * 34], sp[5 * 34]), pk2(sp[6 * 34], sp[7 * 34])}, (v4u*)(J.dst + (size_t)n * J.ldd + 16 * c)); } } } \
        LDS_WAIT(); asm volatile("" ::: "memory"); } while (0)
    CJ ja, jb; f32x4 va[16], vb[16];
    if (q) {
        constexpr int NV2 = I_G + I_D / 2, NV1 = NITEMS - I_IN / 2 - I_IN8 / 2 - NV2, CH = 8;
        const int NV = qsel == 2 ? NV2 : NV1;
#define CW_VIT(v_) cw_vit(qsel, (v_))
        for (int nc = 0; nc < maxc; ++nc) {
            int base = 0; if (lane == 0) base = (int)__hip_atomic_fetch_add(q, (unsigned)CH, __ATOMIC_RELAXED, __HIP_MEMORY_SCOPE_AGENT);
            base = __builtin_amdgcn_readfirstlane(base);
            if (base >= NV) break;
            CW_DECODE(CW_VIT(base), ja); CW_LOAD(ja, va);
#pragma unroll 1
            for (int j = 0; j < CH; j += 2) {
                if (base + j + 1 < NV) { CW_DECODE(CW_VIT(base + j + 1), jb); CW_LOAD(jb, vb); }
                CW_PROC(ja, va);
                if (base + j + 1 >= NV) break;
                if (j + 2 < CH && base + j + 2 < NV) { CW_DECODE(CW_VIT(base + j + 2), ja); CW_LOAD(ja, va); }
                CW_PROC(jb, vb);
                if (base + j + 2 >= NV) break;
            }
        }
#undef CW_VIT
        return;
    }
    int it = it_lo + gw;
    if (it < it_hi) { CW_DECODE(it, ja); CW_LOAD(ja, va); }
    while (it < it_hi) {
        if (it + NGW < it_hi) { CW_DECODE(it + NGW, jb); CW_LOAD(jb, vb); }
        CW_PROC(ja, va);
        it += NGW; if (it >= it_hi) break;
        if (it + NGW < it_hi) { CW_DECODE(it + NGW, ja); CW_LOAD(ja, va); }
        CW_PROC(jb, vb);
        it += NGW;
    }
#undef CW_DECODE
#undef CW_LOAD
#undef CW_ST
#undef CW_PROC
}
__device__ __forceinline__ void p0_prologue(Frame& F, const bool all_weights) {
    const int gw = F.bid * NWAVES + F.wave, NGW = F.G * NWAVES;
    if (all_weights) conv_weights(F, 0, NITEMS, F.bid, F.G);
    else { conv_weights(F, 0, I_IN / 2, F.bid, F.G); conv_weights(F, I_IN, I_IN + I_IN8 / 2, F.bid, F.G); }
    { f32x2* cs = (f32x2*)(F.ws + WS_ROPE);
      for (int i = F.bid * 512 + F.tid; i < SEQ * 64; i += F.G * 512) { const int pos = i >> 6, j = i & 63;
          double inv = 1.0; const double cbase = 0.86596432336006535;
          for (int q = 0; q < j; ++q) inv *= cbase;
          const float ang = (float)pos * (float)inv; float c, s; sincos_d((double)ang, c, s); cs[i] = (f32x2){c, s}; } }
    { v4u* wr = (v4u*)(F.ws + WS_WR);
      for (int i = F.bid * 512 + F.tid; i < NLAYER * 64 * 3 * 2 * 64; i += F.G * 512) {
          const int ln = i & 63, hl = (i >> 6) & 1, q = i >> 7, nt = q % 3, s = (q / 3) % 64, l = q / 192;
          const int n = 16 * nt + (ln & 15); unsigned w[4];
#pragma unroll
          for (int jj = 0; jj < 4; ++jj) { float v[2];
#pragma unroll
              for (int e = 0; e < 2; ++e) { const int k = 32 * s + 8 * (ln >> 4) + 2 * jj + e;
                  float val = 0.f; if (n < 4) val = F.w_group[((size_t)l * D + k) * 4 + n]; else if (n < 36) val = F.w_router[((size_t)l * D + k) * 32 + (n - 4)];
                  val *= F.g_ffn[l * D + k]; const float hi = bf2f((bf16)f2bf(val)); v[e] = hl ? (val - hi) : val; }
              w[jj] = pk2(v[0], v[1]); }
          wr[i] = (v4u){w[0], w[1], w[2], w[3]}; } }
    { bf16* H = (bf16*)(F.ws + WS_H);
      bf16* X1 = (bf16*)(F.ws + WS_X1);
      const f32x4* gr = (const f32x4*)F.g_mix + F.lane;
      f32x4 gq[8];
#pragma unroll
      for (int j = 0; j < 8; ++j) gq[j] = gr[64 * j];
      for (int m = gw; m < T; m += 2 * NGW) {
          f32x4 v[2][8]; float ss[2] = {0.f, 0.f};
#pragma unroll
          for (int r = 0; r < 2; ++r) { const f32x4* xr = (const f32x4*)(F.x + (size_t)(m + r * NGW) * D) + F.lane;
#pragma unroll
              for (int j = 0; j < 8; ++j) v[r][j] = __builtin_nontemporal_load(xr + 64 * j); }
#pragma unroll
          for (int r = 0; r < 2; ++r) { const size_t row = (size_t)(m + r * NGW); v2u* xc = (v2u*)(X1 + row * D) + F.lane; v2u* o8 = (v2u*)(H + row * D) + F.lane; unsigned* of8 = (unsigned*)(F.ws + WS_H8 + row * D) + F.lane;
#pragma unroll
              for (int j = 0; j < 8; ++j) { const f32x4 t = v[r][j]; ss[r] += (t.x * t.x + t.y * t.y) + (t.z * t.z + t.w * t.w); xc[64 * j] = (v2u){pk2(t.x, t.y), pk2(t.z, t.w)}; }
              const float rstd = __builtin_amdgcn_rsqf(wave_sum(ss[r], F.lane) * (1.0f / D) + EPS);
#pragma unroll
              for (int j = 0; j < 8; ++j) { const f32x4 gv = gq[j]; const f32x4 hv = v[r][j] * rstd * gv; v2u o; o.x = pk2(hv.x, hv.y); o.y = pk2(hv.z, hv.w); o8[64 * j] = o; of8[64 * j] = pk4_fp8(hv.x, hv.y, hv.z, hv.w); } } } }
}

typedef short s16x4 __attribute__((ext_vector_type(4)));
__device__ __forceinline__ f32x16 mfma32(bf16x8 a, bf16x8 b, f32x16 c) { return __builtin_amdgcn_mfma_f32_32x32x16_bf16(a, b, c, 0, 0, 0); }
constexpr int PR = 272, PT = 320;
constexpr int RQ = 0, RK = RQ + 64 * PR, RKD = RK + 64 * PR, RV = RKD + 64 * PT, RRT = RV + 64 * PT, RSF = RRT + 128 * PR, RSQ = RSF + 8192, R_END = RSQ + 1024;
static_assert(R_END <= MISC_OFF, "retention LDS");
__device__ __forceinline__ s16x4 trr(const LAS unsigned char* a) { return __builtin_amdgcn_ds_read_tr16_b64_v4i16((LAS s16x4*)a); }
__device__ __forceinline__ bf16x8 cat8(s16x4 a, s16x4 b) { return (bf16x8){a.x, a.y, a.z, a.w, b.x, b.y, b.z, b.w}; }
struct RetPre { v4u q1, q2, k1, k2, v1, v2; f32x4 cs[4]; };
__device__ __forceinline__ void ret_load(RetPre& P, const bf16* zr, const f32x2* csrow, int h, int part) {
    const int j0 = 8 * part;
    P.q1 = *(const v4u*)(zr + 3072 + HD * h + j0); P.q2 = *(const v4u*)(zr + 3072 + HD * h + 64 + j0);
    P.k1 = *(const v4u*)(zr + 4096 + HD * h + j0); P.k2 = *(const v4u*)(zr + 4096 + HD * h + 64 + j0);
    P.v1 = *(const v4u*)(zr + 5120 + HD * h + 16 * part); P.v2 = *(const v4u*)(zr + 5120 + HD * h + 16 * part + 8);
    (void)csrow;
}
__device__ __forceinline__ void ret_load_cs(RetPre& P, const f32x2* csrow, int part) {
    const f32x4* csp = (const f32x4*)(csrow + 8 * part);
#pragma unroll
    for (int p = 0; p < 4; ++p) P.cs[p] = csp[p];
}
__device__ __forceinline__ void ret_write(const RetPre& P, LAS unsigned char* wr, LAS unsigned char* wt, float kd) {
    float ql[8], qh[8], kl[8], kh[8];
#pragma unroll
    for (int p = 0; p < 4; ++p) { const f32x4 c4 = P.cs[p];
#pragma unroll
        for (int e = 0; e < 2; ++e) { const int jj = 2 * p + e; const float c = e ? c4.z : c4.x, s = e ? c4.w : c4.y;
            const float a = e ? bfhi(P.q1[p]) : bflo(P.q1[p]), bb = e ? bfhi(P.q2[p]) : bflo(P.q2[p]);
            ql[jj] = a * c - bb * s; qh[jj] = bb * c + a * s;
            const float ka = e ? bfhi(P.k1[p]) : bflo(P.k1[p]), kb = e ? bfhi(P.k2[p]) : bflo(P.k2[p]);
            kl[jj] = (ka * c - kb * s) * 0.08838834764831845f; kh[jj] = (kb * c + ka * s) * 0.08838834764831845f; } }
    *(LAS v4u*)(wr + RQ) = (v4u){pk2(ql[0], ql[1]), pk2(ql[2], ql[3]), pk2(ql[4], ql[5]), pk2(ql[6], ql[7])};
    *(LAS v4u*)(wr + RQ + 128) = (v4u){pk2(qh[0], qh[1]), pk2(qh[2], qh[3]), pk2(qh[4], qh[5]), pk2(qh[6], qh[7])};
    *(LAS v4u*)(wr + RK) = (v4u){pk2(kl[0], kl[1]), pk2(kl[2], kl[3]), pk2(kl[4], kl[5]), pk2(kl[6], kl[7])};
    *(LAS v4u*)(wr + RK + 128) = (v4u){pk2(kh[0], kh[1]), pk2(kh[2], kh[3]), pk2(kh[4], kh[5]), pk2(kh[6], kh[7])};
    *(LAS v4u*)(wt + RKD) = (v4u){pk2(kl[0] * kd, kl[1] * kd), pk2(kl[2] * kd, kl[3] * kd), pk2(kl[4] * kd, kl[5] * kd), pk2(kl[6] * kd, kl[7] * kd)};
    *(LAS v4u*)(wt + RKD + 128) = (v4u){pk2(kh[0] * kd, kh[1] * kd), pk2(kh[2] * kd, kh[3] * kd), pk2(kh[4] * kd, kh[5] * kd), pk2(kh[6] * kd, kh[7] * kd)};
}
__device__ __forceinline__ void retention_unit(Frame& F, const bf16* Z, bf16* Y, int b, int h) {
    const int tid = F.tid, lane = F.lane, wid = F.wave, l31 = lane & 31, lh = lane >> 5;
    LAS unsigned char* L = F.lds;
    const float xg = __builtin_amdgcn_exp2f(-(float)(5 + h));
    const float lng = -(xg + xg * xg * 0.5f + xg * xg * xg * (1.0f / 3.0f) + xg * xg * xg * xg * 0.25f + xg * xg * xg * xg * xg * 0.2f + xg * xg * xg * xg * xg * xg * (1.0f / 6.0f));
    const float lg2 = lng * 1.4426950408889634f;
    const float cd = __builtin_amdgcn_exp2f(lg2 * 64.0f);
    const f32x2* CS = (const f32x2*)(F.ws + WS_ROPE);
    const int li = tid >> 3, part = tid & 7;
    const float kd = __builtin_amdgcn_exp2f(lg2 * (float)(63 - li));
    LAS unsigned char* const wr = L + li * PR + 16 * part; LAS unsigned char* const wt = L + li * PT + 16 * part; LAS unsigned char* const wv = L + RV + li * PT + 32 * part;
    const int ote = wid >> 1, oti = wid & 1;
    const float qdec = __builtin_amdgcn_exp2f(lg2 * (float)(32 * oti + l31 + 1));
    const LAS unsigned char* const rrow = L + l31 * PR + 16 * lh;
    const int q4 = (lane & 15) >> 2, p4 = lane & 3, blk = (lane >> 4) & 1;
    const LAS unsigned char* const tr8 = L + (q4 + 8 * lh) * PT + 32 * blk + 8 * p4;
    const LAS unsigned char* const tr4 = L + (q4 + 4 * lh) * PT + 32 * blk + 8 * p4;
    f32x16 st[4];
#pragma unroll
    for (int t = 0; t < 4; ++t)
#pragma unroll
        for (int r = 0; r < 16; ++r) st[t][r] = 0.f;
    const bf16* zbase = Z + (size_t)(b * SEQ) * NZ;
    RetPre P;
    ret_load(P, zbase + (size_t)li * NZ, CS + (size_t)li * 64, h, part); ret_load_cs(P, CS + (size_t)li * 64, part);
    ret_write(P, wr, wt, kd); *(LAS v4u*)(wv) = P.v1; *(LAS v4u*)(wv + 16) = P.v2;
    ret_load(P, zbase + (size_t)(CHUNK + li) * NZ, CS + (size_t)(CHUNK + li) * 64, h, part);
    { int lm = lane; asm volatile("" : "+v"(lm) :: "memory");
      if (wid < 4) { const int tj = wid >> 1, ti = wid & 1, l31m = lm & 31, lhm = lm >> 5;
#pragma unroll
        for (int r = 0; r < 16; ++r) { const int j = 32 * tj + (r & 3) + 8 * (r >> 2) + 4 * lhm, i = 32 * ti + l31m; st[0][r] = __builtin_amdgcn_exp2f(lg2 * (float)(i > j ? i - j : j - i)); } } }
    unsigned op[8]; v2u gz[4];
#define RET_FINALIZE(tq) do { const f32x4 q4v = *(const LAS f32x4*)(L + RSQ + (32 * oti + l31) * 16); \
          const float rs = __builtin_amdgcn_rsqf(((q4v.x + q4v.y) + (q4v.z + q4v.w)) * (1.0f / HD) + EPS); \
          bf16* yp = Y + (size_t)((tq) + 32 * oti + l31) * D + 1024 + HD * h + 32 * ote + 4 * lh; \
          _Pragma("unroll") for (int g = 0; g < 4; ++g) { float o4[4]; \
              _Pragma("unroll") for (int e = 0; e < 4; ++e) { const unsigned gw = e < 2 ? gz[g].x : gz[g].y; const float gv = (e & 1) ? bfhi(gw) : bflo(gw); const unsigned ow = op[2 * g + (e >> 1)]; const float ov = (e & 1) ? bfhi(ow) : bflo(ow); o4[e] = ov * rs * gv * __builtin_amdgcn_rcpf(1.0f + __expf(-gv)); } \
              *(v2u*)(yp + 8 * g) = (v2u){pk2(o4[0], o4[1]), pk2(o4[2], o4[3])}; } } while (0)
    __syncthreads();
    for (int n = 0; n < SEQ / CHUNK; ++n) {
        const int t0 = b * SEQ + n * CHUNK;
        if (n + 1 < SEQ / CHUNK) ret_load_cs(P, CS + (size_t)((n + 1) * CHUNK + li) * 64, part);
        if (wid < 4) {
            const int tj = wid >> 1, ti = wid & 1; f32x16 x;
            const LAS unsigned char* ka = rrow + RK + tj * (32 * PR); const LAS unsigned char* qa = rrow + RQ + ti * (32 * PR);
#pragma unroll
            for (int r = 0; r < 16; ++r) x[r] = 0.f;
#pragma unroll
            for (int s = 0; s < 8; ++s) x = mfma32(*(const LAS bf16x8*)(ka + 32 * s), *(const LAS bf16x8*)(qa + 32 * s), x);
#pragma unroll
            for (int s = 0; s < 2; ++s) { v4u f;
                f.x = pk2(x[8 * s + 0] * st[0][8 * s + 0], x[8 * s + 1] * st[0][8 * s + 1]); f.y = pk2(x[8 * s + 2] * st[0][8 * s + 2], x[8 * s + 3] * st[0][8 * s + 3]);
                f.z = pk2(x[8 * s + 4] * st[0][8 * s + 4], x[8 * s + 5] * st[0][8 * s + 5]); f.w = pk2(x[8 * s + 6] * st[0][8 * s + 6], x[8 * s + 7] * st[0][8 * s + 7]);
                *(LAS v4u*)(L + RSF + ((wid * 2 + s) * 64 + lane) * 16) = f; }
        } else {
            const int te = wid - 4;
            LAS unsigned char* rtw = L + RRT + (32 * te + l31) * PR + 8 * lh;
#pragma unroll
            for (int td = 0; td < 4; ++td)
#pragma unroll
                for (int g = 0; g < 4; ++g) { v2u w; w.x = pk2(st[td][4 * g + 0], st[td][4 * g + 1]); w.y = pk2(st[td][4 * g + 2], st[td][4 * g + 3]);
                    *(LAS v2u*)(rtw + 64 * td + 16 * g) = w; }
#pragma unroll
            for (int td = 0; td < 4; ++td)
#pragma unroll
                for (int r = 0; r < 16; ++r) st[td][r] *= cd;
            const LAS unsigned char* va = tr8 + RV + 64 * te; const LAS unsigned char* kda = tr8 + RKD;
#pragma unroll
            for (int s = 0; s < 4; ++s) { const bf16x8 bv = cat8(trr(va + (16 * s) * PT), trr(va + (16 * s + 4) * PT));
#pragma unroll
                for (int td = 0; td < 4; ++td) st[td] = mfma32(cat8(trr(kda + (16 * s) * PT + 64 * td), trr(kda + (16 * s + 4) * PT + 64 * td)), bv, st[td]); }
        }
        if (n > 0) RET_FINALIZE(t0 - CHUNK);
        __syncthreads();
        f32x16 oi, oc;
#pragma unroll
        for (int r = 0; r < 16; ++r) { oi[r] = 0.f; oc[r] = 0.f; }
        { const LAS unsigned char* va = tr4 + RV + 64 * ote; const LAS unsigned char* sf = L + RSF + (oti * 2 * 64 + lane) * 16;
#pragma unroll
          for (int tj = 0; tj < 2; ++tj)
#pragma unroll
            for (int s = 0; s < 2; ++s) { const bf16x8 xb = *(const LAS bf16x8*)(sf + (tj * 2 * 2 + s) * 1024);
                oi = mfma32(cat8(trr(va + (32 * tj + 16 * s) * PT), trr(va + (32 * tj + 16 * s + 8) * PT)), xb, oi); } }
        { const LAS unsigned char* ra = rrow + RRT + ote * (32 * PR); const LAS unsigned char* qa = rrow + RQ + oti * (32 * PR);
#pragma unroll
          for (int s = 0; s < 8; ++s) oc = mfma32(*(const LAS bf16x8*)(ra + 32 * s), *(const LAS bf16x8*)(qa + 32 * s), oc); }
        float sq = 0.f;
#pragma unroll
        for (int r = 0; r < 16; ++r) { oi[r] += qdec * oc[r]; sq += oi[r] * oi[r]; }
        sq += shx(sq, 32, lane);
        if (lane < 32) *(LAS float*)(L + RSQ + ((32 * oti + l31) * 4 + ote) * 4) = sq;
#pragma unroll
        for (int r = 0; r < 8; ++r) op[r] = pk2(oi[2 * r], oi[2 * r + 1]);
        __syncthreads();
        { const bf16* gp = Z + (size_t)(t0 + 32 * oti + l31) * NZ + 6144 + HD * h + 32 * ote + 4 * lh;
#pragma unroll
          for (int g = 0; g < 4; ++g) gz[g] = *(const v2u*)(gp + 8 * g); }
        if (n + 1 < SEQ / CHUNK) { ret_write(P, wr, wt, kd); *(LAS v4u*)(wv) = P.v1; *(LAS v4u*)(wv + 16) = P.v2; }
        if (n + 2 < SEQ / CHUNK) ret_load(P, zbase + (size_t)((n + 2) * CHUNK + li) * NZ, CS + (size_t)((n + 2) * CHUNK + li) * 64, h, part);
        __syncthreads();
    }
    RET_FINALIZE(b * SEQ + SEQ - CHUNK);
#undef RET_FINALIZE
}
__device__ __forceinline__ void conv_items(Frame& F, int l, const bf16* Z, bf16* Y, int cb, int ncb) {
    const float* cw = F.conv_w + (size_t)l * 3 * 1024;
    for (int it = cb * 512 + F.tid; it < (T / 16) * 128; it += ncb * 512) {
        const int tb = (it >> 7) * 16, c0 = 8 * (it & 127);
        float w[3][8];
#pragma unroll
        for (int k = 0; k < 3; ++k) { const f32x4 a = *(const f32x4*)(cw + k * 1024 + c0), b2 = *(const f32x4*)(cw + k * 1024 + c0 + 4);
            w[k][0] = a.x; w[k][1] = a.y; w[k][2] = a.z; w[k][3] = a.w; w[k][4] = b2.x; w[k][5] = b2.y; w[k][6] = b2.z; w[k][7] = b2.w; }
        float u1[8], u2[8];
#pragma unroll
        for (int p = 0; p < 8; ++p) { u1[p] = 0.f; u2[p] = 0.f; }
        if ((tb & (SEQ - 1)) != 0) {
#pragma unroll
            for (int d = 1; d <= 2; ++d) { const bf16* zr = Z + (size_t)(tb - d) * NZ; const v4u ug = *(const v4u*)(zr + 1024 + c0);
#pragma unroll
                for (int p = 0; p < 4; ++p) { const float lo = bflo(ug[p]), hi = bfhi(ug[p]); if (d == 1) { u1[2 * p] = lo; u1[2 * p + 1] = hi; } else { u2[2 * p] = lo; u2[2 * p + 1] = hi; } } }
        }
#pragma unroll 1
        for (int t4 = 0; t4 < 16; t4 += 4) {
        v4u bgq[4], ugq[4];
#pragma unroll
        for (int q = 0; q < 4; ++q) { const bf16* zr = Z + (size_t)(tb + t4 + q) * NZ; bgq[q] = *(const v4u*)(zr + c0); ugq[q] = *(const v4u*)(zr + 1024 + c0); }
#pragma unroll
        for (int q = 0; q < 4; ++q) { const int tt = t4 + q;
            const v4u bg = bgq[q], ug = ugq[q];
            float u0[8], o[8];
#pragma unroll
            for (int p = 0; p < 4; ++p) { u0[2 * p] = bflo(ug[p]); u0[2 * p + 1] = bfhi(ug[p]); }
#pragma unroll
            for (int p = 0; p < 8; ++p) { const float bgv = (p & 1) ? bfhi(bg[p >> 1]) : bflo(bg[p >> 1]); o[p] = bgv * (w[0][p] * u2[p] + w[1][p] * u1[p] + w[2][p] * u0[p]); u2[p] = u1[p]; u1[p] = u0[p]; }
            *(v4u*)(Y + (size_t)(tb + tt) * D + c0) = (v4u){pk2(o[0], o[1]), pk2(o[2], o[3]), pk2(o[4], o[5]), pk2(o[6], o[7])}; } }
    }
}

__device__ __forceinline__ void router_phase(Frame& F, int l, int cw) {
    const int tid = F.tid, lane = F.lane, wid = F.wave, r16 = lane & 15, g4 = lane >> 4;
    LAS unsigned char* L = F.lds;
    LAS float* part = (LAS float*)L;
    LAS int* sel = (LAS int*)(L + 50688); LAS int* hist = (LAS int*)(L + 53248); LAS int* baseS = (LAS int*)(L + 53376); LAS int* rank = (LAS int*)(L + 53760);
    const bf16* X1 = (const bf16*)(F.ws + WS_X1); unsigned char* H8 = F.ws + WS_H8;
    const v4u* WR = (const v4u*)(F.ws + WS_WR) + (size_t)l * (64 * 3 * 2 * 64);
    const float* gff = F.g_ffn + l * D;
    int* list = (int*)(F.ws + WS_LIST); i32x4* info = (i32x4*)(F.ws + WS_INFO);
    unsigned* cntg = F.ctl + cw + 32 * l;
    LAS float* gffL = (LAS float*)(L + 61440); LAS float* lgA = (LAS float*)(L + 69632); LAS float* ssqA = (LAS float*)(L + 94208);
    *(LAS f32x4*)(gffL + 4 * tid) = *(const f32x4*)(gff + 4 * tid);
    for (int grp = F.bid; grp < T / 128; grp += F.G) {
        { int lh_ = lane; asm volatile("" : "+v"(lh_)); if (wid == 0 && lh_ < 32) hist[lh_] = 0; }
#pragma unroll 1
        for (int si = 0; si < 4; ++si) {
            const int r0 = grp * 128 + si * 32;
            LAS float* ssqs = ssqA + si * 256; LAS float* lgs = lgA + si * (32 * 48);
            v4u xb[2][8];
            int ln1 = lane; asm volatile("" : "+v"(ln1));
#pragma unroll
            for (int f = 0; f < 2; ++f) { const bf16* xr = X1 + (size_t)(r0 + 16 * f + (ln1 & 15)) * D + 256 * wid + 8 * (ln1 >> 4);
#pragma unroll
                for (int ks = 0; ks < 8; ++ks) xb[f][ks] = *(const v4u*)(xr + 32 * ks); }
            f32x4 acc[2][3]; float ss[2] = {0.f, 0.f};
#pragma unroll
            for (int f = 0; f < 2; ++f)
#pragma unroll
                for (int nt = 0; nt < 3; ++nt) acc[f][nt] = (f32x4){0.f, 0.f, 0.f, 0.f};
            v4u wfa[8][3];
#pragma unroll
            for (int kb = 0; kb < 8; ++kb) { const v4u* wp = WR + ((size_t)((8 * wid + kb) * 3) * 2) * 64 + ln1;
#pragma unroll
                for (int nt = 0; nt < 3; ++nt) wfa[kb][nt] = wp[nt * 128]; }
            asm volatile("" ::: "memory");
#pragma unroll
            for (int kb = 0; kb < 8; ++kb) {
                v4u wf[1][6];
#pragma unroll
                for (int nt = 0; nt < 3; ++nt) wf[0][nt * 2] = wfa[kb][nt];
#pragma unroll
                for (int k4 = 0; k4 < 1; ++k4) { const int ks = kb + k4;
#pragma unroll
                    for (int f = 0; f < 2; ++f) { const bf16x8 ah = __builtin_bit_cast(bf16x8, xb[f][ks]);
#pragma unroll
                        for (int p = 0; p < 4; ++p) { const float lo = bflo(xb[f][ks][p]), hi = bfhi(xb[f][ks][p]); ss[f] += lo * lo + hi * hi; }
#pragma unroll
                        for (int nt = 0; nt < 3; ++nt) { const bf16x8 bh = __builtin_bit_cast(bf16x8, wf[k4][nt * 2 + 0]);
                            acc[f][nt] = __builtin_amdgcn_mfma_f32_16x16x32_bf16(ah, bh, acc[f][nt], 0, 0, 0); } } }
            }
#pragma unroll
            for (int f = 0; f < 2; ++f) {
#pragma unroll
                for (int nt = 0; nt < 3; ++nt)
#pragma unroll
                    for (int rg = 0; rg < 4; ++rg) part[(wid * 32 + 16 * f + 4 * g4 + rg) * 48 + 16 * nt + r16] = acc[f][nt][rg];
                float q = ss[f]; q += shx(q, 16, lane); q += shx(q, 32, lane);
                if (lane < 16) ssqs[wid * 32 + 16 * f + lane] = q; }
            __syncthreads();
            int ln2 = lane; asm volatile("" : "+v"(ln2));
            const int r16 = ln2 & 15, g4 = ln2 >> 4, tid = wid * 64 + ln2;
#pragma unroll
            for (int f = 0; f < 2; ++f) { float q = 0.f;
#pragma unroll
              for (int w = 0; w < 8; ++w) q += ssqs[w * 32 + 16 * f + r16];
              const float rstd = __builtin_amdgcn_rsqf(q * (1.0f / D) + EPS); unsigned char* hr = H8 + (size_t)(r0 + 16 * f + r16) * D + 256 * wid + 8 * g4; const LAS float* gp = gffL + 256 * wid + 8 * g4;
#pragma unroll
              for (int ks = 0; ks < 8; ++ks) { const f32x4 g0 = *(const LAS f32x4*)(gp + 32 * ks), g1 = *(const LAS f32x4*)(gp + 32 * ks + 4); const v4u xx = xb[f][ks];
                  const f32x4 a = (f32x4){bflo(xx.x), bfhi(xx.x), bflo(xx.y), bfhi(xx.y)} * rstd * g0, b2 = (f32x4){bflo(xx.z), bfhi(xx.z), bflo(xx.w), bfhi(xx.w)} * rstd * g1;
                  *(v2u*)(hr + 32 * ks) = (v2u){pk4_fp8(a.x, a.y, a.z, a.w), pk4_fp8(b2.x, b2.y, b2.z, b2.w)}; } }
            for (int idx = tid; idx < 32 * 48; idx += 512) { const int row = idx / 48, n = idx - row * 48; float a = 0.f;
#pragma unroll
                for (int w = 0; w < 8; ++w) a += part[(w * 32 + row) * 48 + n];
                lgs[idx] = a; }
            __syncthreads();
        }
        int lx = lane; asm volatile("" : "+v"(lx)); const int ts = wid * 64 + lx;
        if (ts < 128) {
                const int tid = ts, si = tid >> 5, tr = tid & 31; const LAS float* ssqs = ssqA + si * 256;
                float q = 0.f;
#pragma unroll
                for (int w = 0; w < 8; ++w) q += ssqs[w * 32 + tr];
                const float rstd = 1.0f / sqrtf(q * (1.0f / D) + EPS);
                const LAS float* lg = lgA + tid * 48; const float* bg = F.b_group + l * 4; const float* br = F.b_router + l * 32;
                int gs = 0; float gm = lg[0] * rstd + bg[0];
#pragma unroll
                for (int n = 1; n < 4; ++n) { const float v = lg[n] * rstd + bg[n]; if (v > gm) { gm = v; gs = n; } }
                float den = 0.f;
#pragma unroll
                for (int n = 0; n < 4; ++n) den += __expf(lg[n] * rstd + bg[n] - gm);
                const float pg = 1.0f / den;
                int i1 = 0; float m1 = lg[4 + 8 * gs] * rstd + br[8 * gs];
#pragma unroll
                for (int n = 1; n < 8; ++n) { const float v = lg[4 + 8 * gs + n] * rstd + br[8 * gs + n]; if (v > m1) { m1 = v; i1 = n; } }
                int i2 = -1; float m2 = 0.f;
#pragma unroll
                for (int n = 0; n < 8; ++n) { const float v = lg[4 + 8 * gs + n] * rstd + br[8 * gs + n]; if (n != i1 && (i2 < 0 || v > m2)) { m2 = v; i2 = n; } }
                const float ex = __expf(m2 - m1), s1 = 1.0f / (1.0f + ex), s2 = ex / (1.0f + ex);
                const int tl = tid;
                sel[tl * 4 + 0] = gs * 8 + i1; sel[tl * 4 + 1] = gs * 8 + i2; sel[tl * 4 + 2] = __builtin_bit_cast(int, pg * s1); sel[tl * 4 + 3] = __builtin_bit_cast(int, pg * s2);
        }
        __syncthreads();
        int ly = lane; asm volatile("" : "+v"(ly)); const int td = wid * 64 + ly;
        int e_my = 0;
        if (td < 256) { e_my = sel[(td >> 1) * 4 + (td & 1)]; rank[td] = atomicAdd((int*)&hist[e_my], 1); }
        __syncthreads();
        if (td < 32) baseS[td] = (int)xb_add(cntg + td, (unsigned)hist[td]);
        __syncthreads();
        if (td < 256) { const int tok = grp * 128 + (td >> 1), slot = baseS[e_my] + rank[td];
            list[(size_t)e_my * T + slot] = tok;
            int* ip = (int*)(info + tok); ip[td & 1] = (e_my << 16) | slot; ip[2 + (td & 1)] = sel[(td >> 1) * 4 + 2 + (td & 1)]; }
        __syncthreads();
    }
}
__device__ __forceinline__ void moe_tables(Frame& F, int l) {
    LAS int* tstart = (LAS int*)(F.MISC + MW_TSTART); LAS int* cnt = (LAS int*)(F.MISC + MW_CNT); LAS int* tile_e = (LAS int*)(F.MISC + MW_TILE);
    __syncthreads();
    if (F.tid < 32) cnt[F.tid] = (int)xb_ld(F.ctl + CW_CNT + 32 * l + F.tid);
    __syncthreads();
    if (F.tid == 0) { int a = 0; for (int e = 0; e < NE; ++e) { tstart[e] = a; int c = cnt[e]; c = c < 0 ? 0 : (c > T ? T : c); a += (c + 255) >> 8; } tstart[NE] = a; }
    __syncthreads();
    for (int rt = F.tid; rt < MAXTILES + 8; rt += 512) { int e = 0; for (int q = 1; q < NE; ++q) if (tstart[q] <= rt) e = q; tile_e[rt] = e; }
    __syncthreads();
}
__device__ __forceinline__ void combine_phase(Frame& F, int l) {
    const LAS int* tstart = (const LAS int*)(F.MISC + MW_TSTART);
    const int gw = F.bid * NWAVES + F.wave, NGW = F.G * NWAVES, lane = F.lane;
    bf16* X1 = (bf16*)(F.ws + WS_X1); const unsigned char* YB = F.ws + WS_YB; bf16* H = (bf16*)(F.ws + WS_H);
    const i32x4* info = (const i32x4*)(F.ws + WS_INFO);
    const float* g = (l + 1 < NLAYER) ? F.g_mix + (l + 1) * D : F.g_final;
    const f32x4* gr = (const f32x4*)g + lane;
    f32x4 gq[8];
#pragma unroll
    for (int j = 0; j < 8; ++j) gq[j] = gr[64 * j];
    i32x4 infn[2]; infn[0] = info[gw]; infn[1] = info[gw + NGW];
    for (int t = gw; t < T; t += 2 * NGW) {
        i32x4 inf[2]; inf[0] = infn[0]; inf[1] = infn[1];
        if (t + 2 * NGW < T) { infn[0] = info[t + 2 * NGW]; infn[1] = info[t + 3 * NGW]; }
        v2u xq[2][8]; unsigned ya[2][8], yb[2][8]; float wa[2], wb[2];
#pragma unroll
        for (int r = 0; r < 2; ++r) { const int tt = t + r * NGW;
            const int ra = 256 * tstart[inf[r].x >> 16] + (inf[r].x & 0xffff), rb = 256 * tstart[inf[r].y >> 16] + (inf[r].y & 0xffff);
            const int wai = inf[r].z, wbi = inf[r].w; wa[r] = __int_as_float(wai); wb[r] = __int_as_float(wbi);
            const v2u* xr = (const v2u*)(X1 + (size_t)tt * D) + lane; const unsigned* pa = (const unsigned*)(YB + (size_t)ra * D) + lane; const unsigned* pb = (const unsigned*)(YB + (size_t)rb * D) + lane;
#pragma unroll
            for (int j = 0; j < 8; ++j) { xq[r][j] = xr[64 * j]; ya[r][j] = pa[64 * j]; yb[r][j] = pb[64 * j]; } }
#pragma unroll
        for (int r = 0; r < 2; ++r) { const int tt = t + r * NGW; f32x4 v[8]; float s = 0.f;
#pragma unroll
            for (int j = 0; j < 8; ++j) { const f32x4 xv = (f32x4){bflo(xq[r][j].x), bfhi(xq[r][j].x), bflo(xq[r][j].y), bfhi(xq[r][j].y)}; const unsigned a = ya[r][j], b2 = yb[r][j];
                const f32x2 a01 = __builtin_amdgcn_cvt_pk_f32_fp8((int)a, false), a23 = __builtin_amdgcn_cvt_pk_f32_fp8((int)a, true), b01 = __builtin_amdgcn_cvt_pk_f32_fp8((int)b2, false), b23 = __builtin_amdgcn_cvt_pk_f32_fp8((int)b2, true);
                v[j].x = xv.x + wa[r] * a01.x + wb[r] * b01.x; v[j].y = xv.y + wa[r] * a01.y + wb[r] * b01.y; v[j].z = xv.z + wa[r] * a23.x + wb[r] * b23.x; v[j].w = xv.w + wa[r] * a23.y + wb[r] * b23.y;
                s += (v[j].x * v[j].x + v[j].y * v[j].y) + (v[j].z * v[j].z + v[j].w * v[j].w); }
            const float rstd = 1.0f / sqrtf(wave_sum(s, lane) * (1.0f / D) + EPS);
            if (l + 1 < NLAYER) { v2u* xo = (v2u*)(X1 + (size_t)tt * D) + lane; v2u* ho = (v2u*)(H + (size_t)tt * D) + lane; unsigned* ho8 = (unsigned*)(F.ws + WS_H8 + (size_t)tt * D) + lane;
#pragma unroll
                for (int j = 0; j < 8; ++j) { xo[64 * j] = (v2u){pk2(v[j].x, v[j].y), pk2(v[j].z, v[j].w)}; const f32x4 gv = gq[j]; const f32x4 hv = v[j] * rstd * gv; v2u o; o.x = pk2(hv.x, hv.y); o.y = pk2(hv.z, hv.w); ho[64 * j] = o; ho8[64 * j] = pk4_fp8(hv.x, hv.y, hv.z, hv.w); } }
            else { f32x4* oo = (f32x4*)(F.out + (size_t)tt * D) + lane;
#pragma unroll
                for (int j = 0; j < 8; ++j) { const f32x4 gv = gq[j]; oo[64 * j] = v[j] * rstd * gv; } } }
    }
}

struct Args { const float* in[14]; float* out; unsigned char* ws; int ph_lo, ph_hi; };
__global__ void __launch_bounds__(NWAVES * 64, 2) mk_fwd(Args args) {
    extern __shared__ __attribute__((aligned(16))) unsigned char lds[];
    Frame F;
    F.lds = (LAS unsigned char*)lds; F.MISC = (volatile LAS unsigned*)(F.lds + MISC_OFF);
    F.tid = threadIdx.x; F.lane = F.tid & 63; F.wave = __builtin_amdgcn_readfirstlane(F.tid >> 6); F.G = gridDim.x; F.bid = blockIdx.x;
    F.ws = args.ws; F.ctl = (unsigned*)(args.ws + WS_CTL); F.out = args.out;
    F.x = args.in[0]; F.g_mix = args.in[1]; F.w_in = args.in[2]; F.conv_w = args.in[3]; F.w_out = args.in[4]; F.g_ffn = args.in[5]; F.w_group = args.in[6]; F.b_group = args.in[7];
    F.w_router = args.in[8]; F.b_router = args.in[9]; F.w_gate = args.in[10]; F.w_up = args.in[11]; F.w_down = args.in[12]; F.g_final = args.in[13];
    for (int u = F.tid; u < (LDS_BYTES - MISC_OFF) / 4; u += NWAVES * 64) ((LAS unsigned*)(F.lds + MISC_OFF))[u] = 0u;
    __syncthreads();
    XcdBarrier bar; bar.bar = F.ctl + CW_BAR; bar.x = 0; bar.st = nullptr;
#if !MK_PER_PHASE
    bar = xcd_barrier_post(F.ctl + CW_BAR, F.MISC + MW_BAR);
#endif
    const int lo = args.ph_lo, hi = args.ph_hi;
#define REFRESH() do { unsigned m_ = ~0u; asm volatile("" : "+s"(m_)); int l_ = (int)__builtin_amdgcn_mbcnt_hi(m_, __builtin_amdgcn_mbcnt_lo(m_, 0u)); F.lane = l_; F.tid = F.wave * 64 + l_; } while (0)
#define IN(k) (!MK_PER_PHASE || (lo <= (k) && (k) < hi))
#define DUP(k) ((DUP_MASK >> (k)) & 1)
#define SEAM(k) do { if (IN(k) && IN((k) + 1)) xcd_barrier(bar); } while (0)
    bf16* Hb = (bf16*)(F.ws + WS_H); bf16* Zb = (bf16*)(F.ws + WS_Z); bf16* Yb = (bf16*)(F.ws + WS_Y); bf16* X1 = (bf16*)(F.ws + WS_X1);
    unsigned char* HID = F.ws + WS_HID; unsigned char* YBb = F.ws + WS_YB;

    if (IN(0)) { for (int rep = 0; rep <= DUP(0); ++rep) { if (rep) xcd_barrier(bar); REFRESH(); p0_prologue(F, F.G != 256); } } SEAM(0);
    for (int l = 0; l < NLAYER; ++l) {
        const int pb = 1 + 7 * l;
        if (IN(pb + 0)) {
            const bool side = (l == 0 && F.G == 256);
            constexpr int NCV = NCV_SET;
            if (side && F.bid < NCV) { REFRESH(); conv_weights(F, 0, 0, 0, 1, F.ctl + CW_Q); }
            else { const int gG = side ? F.G - NCV : F.G, gc = side ? F.bid - NCV : F.bid;
            { pg8::DenseOrder S{T / 256, 12, gG, gc, 2 * D, (const char*)Hb, (const char*)(F.ws + WS_WIN) + (size_t)l * NZ * D * 2};
              pg8::EpiConvIn E{Zb, NZ};
              pg8::gemm_phase<pg8::EpiConvIn, pg8::DenseOrder>(F.lds, 2 * D, S, E, F.wave); }
            { pg8::DenseOrder S{T / 256, 16, gG, gc, D, (const char*)(F.ws + WS_H8), (const char*)(F.ws + WS_WIN8) + (size_t)l * 4096 * D};
              pg8::EpiBf16 E{Zb, NZ, 3072};
              pg8::gemm_phase<pg8::EpiBf16, pg8::DenseOrder, true>(F.lds, D, S, E, F.wave); }
            if (side) { REFRESH(); conv_weights(F, 0, 0, 0, 1, F.ctl + CW_Q); } }
        } SEAM(pb + 0);
        if (IN(pb + 1)) {
            for (int rep = 0; rep <= DUP(2); ++rep) { if (rep) xcd_barrier(bar);
            REFRESH();
            for (int u = F.bid; u < 128; u += F.G) retention_unit(F, Zb, Yb, u >> 3, u & 7);
            const bool split = F.G >= 256;
            REFRESH();
            if (!split || F.bid >= 128) conv_items(F, l, Zb, Yb, split ? F.bid - 128 : F.bid, split ? F.G - 128 : F.G);
            if (F.G == 256 && F.bid >= 128) { REFRESH(); conv_weights(F, 0, 0, 0, 1, F.ctl + CW_Q2, 2, l == 0 ? P2_CHUNKS : 0x7fffffff); } }
        } SEAM(pb + 1);
        if (IN(pb + 2)) {
            pg8::DenseOrder S{T / 256, D / 256, F.G, F.bid, 2 * D, (const char*)Yb, (const char*)(F.ws + WS_WOUT) + (size_t)l * D * D * 2};
            pg8::EpiResid E{X1, D};
            for (int rep = 0; rep <= 0; ++rep) { if (rep) xcd_barrier(bar); pg8::gemm_phase<pg8::EpiResid, pg8::DenseOrder>(F.lds, 2 * D, S, E, F.wave); }
        } SEAM(pb + 2);
        if (IN(pb + 3)) { if (DUP(4)) { REFRESH(); router_phase(F, l, CW_CNT + 64); xcd_barrier(bar); } REFRESH(); router_phase(F, l, CW_CNT); } SEAM(pb + 3);
        if (IN(pb + 4)) {
            REFRESH(); moe_tables(F, l);
            pg8::MoeOrder<true> S{(int)F.MISC[MW_TSTART + NE], F.G, F.bid, D, (const char*)(F.ws + WS_H8), (const char*)(F.ws + WS_W13) + (size_t)l * NE * 2048 * D, (size_t)2048 * D,
                (const int*)(F.ws + WS_LIST), (const LAS int*)(F.MISC + MW_TILE), (const LAS int*)(F.MISC + MW_TSTART), (const LAS int*)(F.MISC + MW_CNT)};
            pg8::EpiSwiglu E{HID};
            for (int rep = 0; rep <= DUP(5); ++rep) { if (rep) xcd_barrier(bar); pg8::gemm_phase<pg8::EpiSwiglu, pg8::MoeOrder<true>, true>(F.lds, D, S, E, F.wave); }
        } SEAM(pb + 4);
        if (IN(pb + 5)) {
            REFRESH(); moe_tables(F, l);
            pg8::MoeOrder<false> S{(int)F.MISC[MW_TSTART + NE], F.G, F.bid, DE, (const char*)HID, (const char*)(F.ws + WS_W2) + (size_t)l * NE * D * DE, (size_t)D * DE,
                nullptr, (const LAS int*)(F.MISC + MW_TILE), (const LAS int*)(F.MISC + MW_TSTART), (const LAS int*)(F.MISC + MW_CNT)};
            pg8::EpiFp8 E{YBb, D};
            for (int rep = 0; rep <= DUP(6); ++rep) { if (rep) xcd_barrier(bar); pg8::gemm_phase<pg8::EpiFp8, pg8::MoeOrder<false>, true>(F.lds, DE, S, E, F.wave); }
        } SEAM(pb + 5);
        if (IN(pb + 6)) { REFRESH(); moe_tables(F, l); for (int rep = 0; rep <= (DUP(7) && l == NLAYER - 1 ? 1 : 0); ++rep) { if (rep) xcd_barrier(bar); combine_phase(F, l); } } SEAM(pb + 6);
    }
#undef IN
#undef SEAM
}

extern "C" void kernel_launch(void* const* d_in, const int* in_sizes, int n_in, void* d_out, int out_size, void* d_ws, size_t ws_size, hipStream_t stream) {
    static int grid = 0;
    if (grid == 0) {
        if (n_in != 14 || in_sizes[0] != T * D || out_size != T * D || ws_size < WS_END) { fprintf(stderr, "kernel_launch: unexpected shapes (n_in %d, in0 %d, out %d, ws %zu < %zu); nothing launched\n", n_in, n_in > 0 ? in_sizes[0] : -1, out_size, ws_size, (size_t)WS_END); grid = -1; return; }
        int dev = 0, cus = 0, per_cu = 0;
        if (hipGetDevice(&dev) != hipSuccess || hipDeviceGetAttribute(&cus, hipDeviceAttributeMultiprocessorCount, dev) != hipSuccess) { grid = -1; return; }
        if (hipFuncSetAttribute((const void*)mk_fwd, hipFuncAttributeMaxDynamicSharedMemorySize, LDS_BYTES) != hipSuccess) { fprintf(stderr, "kernel_launch: hipFuncSetAttribute failed\n"); grid = -1; return; }
        if (hipOccupancyMaxActiveBlocksPerMultiprocessor(&per_cu, (const void*)mk_fwd, NWAVES * 64, LDS_BYTES) != hipSuccess || per_cu < 1)
            fprintf(stderr, "kernel_launch: note: occupancy query reports %d workgroups per CU\n", per_cu);
        (void)hipGetLastError();
        grid = cus;
    }
    if (grid < 0) return;
    if (hipMemsetAsync((char*)d_ws + WS_CTL, 0, CTL_ZERO_BYTES, stream) != hipSuccess) { fprintf(stderr, "kernel_launch: memset failed\n"); return; }
    Args a{};
    for (int i = 0; i < 14; ++i) a.in[i] = (const float*)d_in[i];
    a.out = (float*)d_out; a.ws = (unsigned char*)d_ws;
#if MK_PER_PHASE
    for (int p = 0; p < NPHASE; ++p) { a.ph_lo = p; a.ph_hi = p + 1; hipLaunchKernelGGL(mk_fwd, dim3(grid), dim3(NWAVES * 64), LDS_BYTES, stream, a); }
#else
    a.ph_lo = 0; a.ph_hi = NPHASE;
    hipLaunchKernelGGL(mk_fwd, dim3(grid), dim3(NWAVES * 64), LDS_BYTES, stream, a);
#endif
    const hipError_t le = hipPeekAtLastError();
    if (le != hipSuccess) fprintf(stderr, "kernel_launch: launch failed: %s\n", hipGetErrorName(le));
}
```
